# Optimizing an MI355X kernel written in HIP

```python
import math
import numpy as np
import jax
import jax.numpy as jnp
from jax import lax

D_MODEL = 1024
BATCH = 8
SEQ = 8192
DEPTH = 4

GRID_W = 64
CTX_LEN = 256
N_MIXERS = 3
FF_DIM = 4 * D_MODEL
NORM_EPS = 1e-6
GM_CHUNK = 128
GM_HALF = 3 * D_MODEL
GM_GROUPS = 8
NA_HEAD_DIM = 64
NA_HEADS = D_MODEL // NA_HEAD_DIM
NA_KH_MAX = 8
NA_KW = 16
NA_QBLOCK = 16
NA_KSPAN = 2 * NA_QBLOCK
ML_HEADS = 8
ML_V_DIM = D_MODEL // ML_HEADS
ML_QK_DIM = ML_V_DIM // 2
ML_INNER = ML_HEADS * ML_V_DIM
ML_CHUNK = 64
ROPE_BASE = 10000.0
N_A = (DEPTH + 2) // 3
N_B = (DEPTH + 1) // 3
N_C = DEPTH // 3

kernel_name = 'hybrid_gmlp_natten_mlstm_prefix_dit'


def rmsnorm(x, g):
    x32 = x.astype(jnp.float32)
    y = x32 * lax.rsqrt(jnp.mean(x32 * x32, axis=-1, keepdims=True) + NORM_EPS)
    return (y * g.astype(jnp.float32)).astype(x.dtype)


def layernorm(x, g):
    x32 = x.astype(jnp.float32)
    xc = x32 - jnp.mean(x32, axis=-1, keepdims=True)
    y = xc * lax.rsqrt(jnp.mean(xc * xc, axis=-1, keepdims=True) + NORM_EPS)
    return (y * g.astype(jnp.float32)).astype(x.dtype)


def sqrelu_mlp(h, w1, w2):
    return jnp.square(jax.nn.relu(h @ w1)) @ w2


def chunk_gmlp(h, w_in, b_in, ln_g, w_s, b_s, w_out):
    bsz, t, _ = h.shape
    z = jax.nn.gelu(h @ w_in + b_in)
    u, v = jnp.split(z, 2, axis=-1)
    v = layernorm(v, ln_g)
    v = v.reshape(bsz, t // GM_CHUNK, GM_CHUNK, GM_GROUPS, GM_HALF // GM_GROUPS)
    v = jnp.einsum('gpq,bnqgc->bnpgc', w_s, v) + b_s.T[None, None, :, :, None]
    return (u * v.reshape(bsz, t, GM_HALF)) @ w_out


def na_tables():
    cols = np.arange(GRID_W)
    win_start = np.clip(cols - NA_KW // 2, 0, GRID_W - NA_KW)
    n_blk = GRID_W // NA_QBLOCK
    blk_start = np.clip(win_start[::NA_QBLOCK], 0, GRID_W - NA_KSPAN)
    key_cols = blk_start[:, None] + np.arange(NA_KSPAN)[None, :]
    q_cols = cols.reshape(n_blk, NA_QBLOCK)
    ws = win_start.reshape(n_blk, NA_QBLOCK)[..., None]
    kc = key_cols[:, None, :]
    valid = (kc >= ws) & (kc < ws + NA_KW)
    dcol = np.clip(kc - q_cols[..., None], -(NA_KW - 1), NA_KW - 1) + NA_KW - 1
    return key_cols, valid, dcol


def neighbourhood_attention(h, hc, w_qkv, b_qkv, rpb, w_o, b_o, need_ctx):
    bsz, t, _ = h.shape
    lc = hc.shape[1]
    rows = t // GRID_W
    kh = min(NA_KH_MAX, rows)
    scale = NA_HEAD_DIM ** -0.5
    n_blk = GRID_W // NA_QBLOCK
    qkv = (h @ w_qkv + b_qkv).reshape(bsz, rows, GRID_W, 3, NA_HEADS, NA_HEAD_DIM)
    qkv = jnp.transpose(qkv, (3, 0, 4, 1, 2, 5))
    q, k, v = qkv[0], qkv[1], qkv[2]
    qkv_c = jnp.transpose((hc @ w_qkv + b_qkv).reshape(bsz, lc, 3, NA_HEADS, NA_HEAD_DIM), (2, 0, 3, 1, 4))
    qc, kc, vc = qkv_c[0], qkv_c[1], qkv_c[2]
    key_cols, valid, dcol = na_tables()
    mask = jnp.asarray(valid)[:, :, None, :]
    n_lat = kh * NA_KSPAN

    def row_step(r):
        rs = jnp.clip(r - kh // 2, 0, rows - kh)
        q_r = lax.dynamic_index_in_dim(q, r, axis=2, keepdims=False)
        q_r = q_r.reshape(bsz, NA_HEADS, n_blk, NA_QBLOCK, NA_HEAD_DIM)
        k_b = lax.dynamic_slice_in_dim(k, rs, kh, axis=2)[:, :, :, key_cols]
        v_b = lax.dynamic_slice_in_dim(v, rs, kh, axis=2)[:, :, :, key_cols]
        drow = rs + jnp.arange(kh) - r + NA_KH_MAX - 1
        bias = jnp.transpose(rpb[:, drow][:, :, dcol], (0, 2, 3, 1, 4))
        s_lat = jnp.einsum('bhjqd,bhrjkd->bhjqrk', q_r, k_b).astype(jnp.float32) * scale + bias.astype(jnp.float32)
        s_lat = jnp.where(mask, s_lat, jnp.float32(-1e30)).reshape(bsz, NA_HEADS, n_blk, NA_QBLOCK, n_lat)
        s_ctx = jnp.einsum('bhjqd,bhcd->bhjqc', q_r, kc).astype(jnp.float32) * scale
        p = jax.nn.softmax(jnp.concatenate([s_lat, s_ctx], axis=-1), axis=-1).astype(v.dtype)
        p_lat = p[..., :n_lat].reshape(bsz, NA_HEADS, n_blk, NA_QBLOCK, kh, NA_KSPAN)
        o = jnp.einsum('bhjqrk,bhrjkd->bhjqd', p_lat, v_b) + jnp.einsum('bhjqc,bhcd->bhjqd', p[..., n_lat:], vc)
        return o.reshape(bsz, NA_HEADS, GRID_W, NA_HEAD_DIM)

    out = lax.map(row_step, jnp.arange(rows))
    y = jnp.transpose(out, (1, 0, 3, 2, 4)).reshape(bsz, t, D_MODEL) @ w_o + b_o
    yc = None
    if need_ctx:
        sc = jnp.einsum('bhqd,bhkd->bhqk', qc, kc).astype(jnp.float32) * scale
        pc = jax.nn.softmax(sc, axis=-1).astype(vc.dtype)
        yc = jnp.einsum('bhqk,bhkd->bqhd', pc, vc).reshape(bsz, lc, D_MODEL) @ w_o + b_o
    return y, yc


def axial_rope(x):
    t = x.shape[1]
    pos = jnp.arange(t)
    row = (pos // GRID_W).astype(jnp.float32)
    col = (pos % GRID_W).astype(jnp.float32)
    d_axis = x.shape[-1] // 2
    inv = ROPE_BASE ** (-jnp.arange(0, d_axis, 2, dtype=jnp.float32) / d_axis)

    def rot(xa, p):
        ang = p[:, None] * inv[None, :]
        cos = jnp.cos(ang)[None, :, None, :]
        sin = jnp.sin(ang)[None, :, None, :]
        x1, x2 = jnp.split(xa, 2, axis=-1)
        return jnp.concatenate([x1 * cos - x2 * sin, x1 * sin + x2 * cos], axis=-1)

    x32 = x.astype(jnp.float32)
    return jnp.concatenate([rot(x32[..., :d_axis], row), rot(x32[..., d_axis:], col)], axis=-1).astype(x.dtype)


def mlstm_scan(q, k, v, ig, lf, state):
    bsz, nh, t, _ = q.shape
    dv = v.shape[-1]
    nc = t // ML_CHUNK
    tri = jnp.tril(jnp.ones((ML_CHUNK, ML_CHUNK), dtype=bool))

    def to_chunks(a):
        return jnp.moveaxis(a.reshape(bsz, nh, nc, ML_CHUNK, *a.shape[3:]), 2, 0)

    def step(carry, inp):
        c_st, n_st, m_st = carry
        qc, kc, vc, ic, fc = inp
        b = jnp.cumsum(fc, axis=-1)
        dmat = jnp.where(tri, b[..., :, None] - b[..., None, :] + ic[..., None, :], -jnp.inf)
        g = b + m_st[..., None]
        m_t = jnp.maximum(g, jnp.max(dmat, axis=-1))
        a = jnp.einsum('bhtd,bhsd->bhts', qc, kc) * jnp.exp(dmat - m_t[..., None])
        inter = jnp.exp(g - m_t)
        num = inter[..., None] * jnp.einsum('bhtd,bhde->bhte', qc, c_st) + jnp.einsum('bhts,bhse->bhte', a, vc)
        den = inter * jnp.einsum('bhtd,bhd->bht', qc, n_st) + jnp.sum(a, axis=-1)
        h = num / jnp.maximum(jnp.abs(den), jnp.exp(-m_t))[..., None]
        b_last = b[..., -1]
        a_s = b_last[..., None] - b + ic
        m_new = jnp.maximum(b_last + m_st, jnp.max(a_s, axis=-1))
        w_s = jnp.exp(a_s - m_new[..., None])
        decay = jnp.exp(b_last + m_st - m_new)
        c_new = decay[..., None, None] * c_st + jnp.einsum('bhs,bhsd,bhse->bhde', w_s, kc, vc)
        n_new = decay[..., None] * n_st + jnp.einsum('bhs,bhsd->bhd', w_s, kc)
        return (c_new, n_new, m_new), h

    state, h = lax.scan(step, state, (to_chunks(q), to_chunks(k), to_chunks(v), to_chunks(ig), to_chunks(lf)))
    return jnp.moveaxis(h, 0, 2).reshape(bsz, nh, t, dv), state


def mlstm_mixer(h, hc, w_in, w_gate, b_gate, norm_g, w_out, need_ctx):
    qk_w = ML_HEADS * ML_QK_DIM

    def heads(a):
        return jnp.transpose(a, (0, 2, 1, 3)).astype(jnp.float32)

    def project(z, rope):
        bsz, t, _ = z.shape
        p = z @ w_in
        q = p[..., :qk_w].reshape(bsz, t, ML_HEADS, ML_QK_DIM)
        k = p[..., qk_w:2 * qk_w].reshape(bsz, t, ML_HEADS, ML_QK_DIM)
        v = p[..., 2 * qk_w:2 * qk_w + ML_INNER].reshape(bsz, t, ML_HEADS, ML_V_DIM)
        o = p[..., 2 * qk_w + ML_INNER:]
        if rope:
            q, k = axial_rope(q), axial_rope(k)
        g = jnp.einsum('btd,zdg->zbgt', z, w_gate).astype(jnp.float32) + b_gate.astype(jnp.float32)[:, None, :, None]
        ig = g[:, :, :ML_HEADS]
        lf = jax.nn.log_sigmoid(g[:, :, ML_HEADS:])
        return heads(q), heads(k) * (ML_QK_DIM ** -0.5), heads(v), o, ig, lf

    def readout(hh, o):
        bsz, _, t, _ = hh.shape
        hh = hh * lax.rsqrt(jnp.mean(hh * hh, axis=-1, keepdims=True) + NORM_EPS)
        hh = jnp.transpose(hh, (0, 2, 1, 3)).reshape(bsz, t, ML_INNER) * norm_g.astype(jnp.float32)
        return (hh.astype(o.dtype) * jax.nn.sigmoid(o)) @ w_out

    def flip(a):
        return jnp.flip(a, axis=2)

    bsz = h.shape[0]
    q, k, v, o, ig, lf = project(h, True)
    qc, kc, vc, oc, igc, lfc = project(hc, False)
    zero = (jnp.zeros((bsz, ML_HEADS, ML_QK_DIM, ML_V_DIM), jnp.float32),
            jnp.zeros((bsz, ML_HEADS, ML_QK_DIM), jnp.float32),
            jnp.zeros((bsz, ML_HEADS), jnp.float32))
    hc_f, st_f = mlstm_scan(qc, kc, vc, igc[0], lfc[0], zero)
    h_f, _ = mlstm_scan(q, k, v, ig[0], lf[0], st_f)
    hc_b, st_b = mlstm_scan(flip(qc), flip(kc), flip(vc), flip(igc[1]), flip(lfc[1]), zero)
    h_b, _ = mlstm_scan(flip(q), flip(k), flip(v), flip(ig[1]), flip(lf[1]), st_b)
    y = readout(h_f + flip(h_b), o)
    yc = readout(hc_f + flip(hc_b), oc) if need_ctx else None
    return y, yc


def setup_inputs(seed: int = 0) -> dict:
    key = jax.random.key(seed)
    keys = jax.random.split(key, 28)

    def nrm(i, shape, scale):
        return jax.random.normal(keys[i], shape, jnp.float32) * scale

    D = D_MODEL
    qk_w = ML_HEADS * ML_QK_DIM
    forget_bias = jnp.linspace(3.0, 6.0, ML_HEADS, dtype=jnp.float32)[None, None, :]
    ml_b_gate = jnp.concatenate([nrm(22, (N_C, 2, ML_HEADS), 0.1),
                                 forget_bias + nrm(23, (N_C, 2, ML_HEADS), 0.1)], axis=-1)
    return {
        'x': nrm(0, (BATCH, SEQ, D), 1.0),
        'c': nrm(1, (BATCH, D), 1.0),
        'ctx': nrm(2, (BATCH, CTX_LEN, D), 1.0),
        'c_ctx': nrm(3, (D,), 1.0),
        'ada_w': nrm(4, (DEPTH, D, 6 * D), 0.5 * D ** -0.5),
        'ada_b': nrm(5, (DEPTH, 6 * D), 0.02),
        'norm_g': 1.0 + nrm(6, (DEPTH, 4, D), 0.05),
        'ffn_w1': nrm(7, (DEPTH, D, FF_DIM), D ** -0.5),
        'ffn_w2': nrm(8, (DEPTH, FF_DIM, D), FF_DIM ** -0.5),
        'gm_w_in': nrm(9, (N_A, D, 2 * GM_HALF), D ** -0.5),
        'gm_b_in': nrm(10, (N_A, 2 * GM_HALF), 0.02),
        'gm_ln_g': 1.0 + nrm(11, (N_A, GM_HALF), 0.05),
        'gm_ws': nrm(12, (N_A, GM_GROUPS, GM_CHUNK, GM_CHUNK), GM_CHUNK ** -0.5),
        'gm_bs': 1.0 + nrm(13, (N_A, GM_GROUPS, GM_CHUNK), 0.1),
        'gm_w_out': nrm(14, (N_A, GM_HALF, D), GM_HALF ** -0.5),
        'na_w_qkv': nrm(15, (N_B, D, 3 * D), D ** -0.5),
        'na_b_qkv': nrm(16, (N_B, 3 * D), 0.02),
        'na_rpb': nrm(17, (N_B, NA_HEADS, 2 * NA_KH_MAX - 1, 2 * NA_KW - 1), 0.1),
        'na_w_o': nrm(18, (N_B, D, D), D ** -0.5),
        'na_b_o': nrm(19, (N_B, D), 0.02),
        'ml_w_in': nrm(20, (N_C, D, 2 * qk_w + 2 * ML_INNER), D ** -0.5),
        'ml_w_gate': nrm(21, (N_C, 2, D, 2 * ML_HEADS), D ** -0.5),
        'ml_b_gate': ml_b_gate,
        'ml_norm_g': 1.0 + nrm(24, (N_C, ML_INNER), 0.05),
        'ml_w_out': nrm(25, (N_C, ML_INNER, D), ML_INNER ** -0.5),
    }


def reference(x, c, ctx, c_ctx, ada_w, ada_b, norm_g, ffn_w1, ffn_w2,
              gm_w_in, gm_b_in, gm_ln_g, gm_ws, gm_bs, gm_w_out,
              na_w_qkv, na_b_qkv, na_rpb, na_w_o, na_b_o,
              ml_w_in, ml_w_gate, ml_b_gate, ml_norm_g, ml_w_out):
    xc = ctx
    c_act = jax.nn.silu(c)
    cc_act = jax.nn.silu(c_ctx)
    for i in range(DEPTH):
        kind, j = i % N_MIXERS, i // N_MIXERS
        need_ctx = i < DEPTH - 1
        mod = [m[:, None, :] for m in jnp.split(c_act @ ada_w[i] + ada_b[i], 6, axis=-1)]
        modc = jnp.split(cc_act @ ada_w[i] + ada_b[i], 6, axis=-1)
        h = rmsnorm(x, norm_g[i, 0]) * (1.0 + mod[1]) + mod[0]
        hc = rmsnorm(xc, norm_g[i, 0]) * (1.0 + modc[1]) + modc[0]
        if kind == 0:
            y = chunk_gmlp(h, gm_w_in[j], gm_b_in[j], gm_ln_g[j], gm_ws[j], gm_bs[j], gm_w_out[j])
            yc = chunk_gmlp(hc, gm_w_in[j], gm_b_in[j], gm_ln_g[j], gm_ws[j], gm_bs[j], gm_w_out[j]) if need_ctx else None
        elif kind == 1:
            y, yc = neighbourhood_attention(h, hc, na_w_qkv[j], na_b_qkv[j], na_rpb[j], na_w_o[j], na_b_o[j], need_ctx)
        else:
            y, yc = mlstm_mixer(h, hc, ml_w_in[j], ml_w_gate[j], ml_b_gate[j], ml_norm_g[j], ml_w_out[j], need_ctx)
        x = x + mod[2] * rmsnorm(y, norm_g[i, 1])
        h = rmsnorm(x, norm_g[i, 2]) * (1.0 + mod[4]) + mod[3]
        x = x + mod[5] * rmsnorm(sqrelu_mlp(h, ffn_w1[i], ffn_w2[i]), norm_g[i, 3])
        if need_ctx:
            xc = xc + modc[2] * rmsnorm(yc, norm_g[i, 1])
            hc = rmsnorm(xc, norm_g[i, 2]) * (1.0 + modc[4]) + modc[3]
            xc = xc + modc[5] * rmsnorm(sqrelu_mlp(hc, ffn_w1[i], ffn_w2[i]), norm_g[i, 3])
    return x
```

```cpp
#include <hip/hip_runtime.h>
#include <cstdio>
#include <cstdint>
namespace pg8 {
#define PG8_LAS __attribute__((address_space(3)))
typedef unsigned short bf16_t;
typedef short bf16x8 __attribute__((ext_vector_type(8)));
typedef float f32x4 __attribute__((ext_vector_type(4)));
typedef unsigned u32x4 __attribute__((ext_vector_type(4)));
constexpr int BM = 256, BK = 64, HALF = 128, HTB = HALF * BK * 2  , STAGE_BYTES = 8 * HTB, NXCD = 8, WGM = 8;

__host__ __device__ __forceinline__ int lds_byte(int r, int c) { const int st = (r >> 4) * 2 + (c >> 5), rr = r & 15, cc = c & 31, ob = rr * 64 + cc * 2; return st * 1024 + (ob ^ (((ob >> 9) & 1) << 5)); }
__host__ __device__ __forceinline__ void stage_rc(int b, int& R, int& C) { const int st = b / 1024, sb = b % 1024, swz = sb ^ (((sb >> 9) & 1) << 5); R = (st >> 1) * 16 + swz / 64; C = (st & 1) * 32 + (swz % 64) / 2; }
__host__ __device__ __forceinline__ int perm32(int rho) { const int n = rho >> 4, i = rho & 15; return 8 * (i >> 2) + 4 * n + (i & 3); }

struct Unit { int pm, pn; };
struct Gemm { const bf16_t* A; const bf16_t* Bt; int M, N, K; };

struct StaticOrder {
    int nM, nN, nwg, G, c;
    __host__ __device__ void init(int M, int N, int G_, int c_) { nM = M / BM; nN = N / BM; nwg = nM * nN; G = G_; c = c_; }
    __host__ __device__ bool next(int i, Unit& u) const {
        const long L = (long)i * G + c; if (L >= nwg) return false;
        int wgid = (int)L; { const int q = nwg / NXCD, r = nwg % NXCD, xcd = wgid % NXCD, off = wgid / NXCD; wgid = (xcd < r ? xcd * (q + 1) : r * (q + 1) + (xcd - r) * q) + off; }
        const int nig = WGM * nN, gid = wgid / nig, fm = gid * WGM, gsz = (nM - fm) < WGM ? (nM - fm) : WGM;
        u.pm = fm + ((wgid % nig) % gsz); u.pn = (wgid % nig) / gsz; return true;
    }
    __device__ __forceinline__ void a_ready(const Unit&) const {}
    __device__ __forceinline__ void done(const Unit&) const {}
};

__device__ __forceinline__ unsigned cvt_pk_bf16(float lo, float hi) { unsigned r; asm volatile("v_cvt_pk_bf16_f32 %0, %1, %2" : "=v"(r) : "v"(lo), "v"(hi)); return r; }
__device__ __forceinline__ float gelu_tanh(float x) {
    const float z = x * (1.0f + 0.044715f * x * x);
    return x * __builtin_amdgcn_rcpf(1.0f + __builtin_amdgcn_exp2f(-2.302208198f * z));
}
template <int ACT> __device__ __forceinline__ f32x4 act4(f32x4 v) {
    if (ACT == 1) { v[0] = gelu_tanh(v[0]); v[1] = gelu_tanh(v[1]); v[2] = gelu_tanh(v[2]); v[3] = gelu_tanh(v[3]); }
    if (ACT == 2) { v[0] = fmaxf(v[0], 0.f); v[1] = fmaxf(v[1], 0.f); v[2] = fmaxf(v[2], 0.f); v[3] = fmaxf(v[3], 0.f); v = v * v; }
    return v;
}

template <int ACT> struct EpiBf16 {
    static constexpr bool PERM = true, AFTER_DRAIN = false;
    bf16_t* O; int ldc; const float* bias; int split_cols; size_t split_stride; float scale0;
    __device__ __forceinline__ void operator()(const f32x4 (&acc)[2][2][4][2], const Unit& u, int wr, int wc, int fr, int fq) const {
        const int row0 = u.pm * BM + wr * 64 + fr; int colt = u.pn * BM; bf16_t* base = O;
        float sc = 1.f; if (split_cols) { const int t = colt / split_cols; base += (size_t)t * split_stride; colt -= t * split_cols; if (t == 0) sc = scale0; }
        const int col0 = colt + wc * 32 + 8 * fq, bcol0 = u.pn * BM + wc * 32 + 8 * fq;
        f32x4 bv[2][2];
#pragma unroll
        for (int bj = 0; bj < 2; ++bj)
#pragma unroll
            for (int n = 0; n < 2; ++n) bv[bj][n] = bias ? *(const f32x4*)(bias + bcol0 + bj * HALF + 4 * n) : (f32x4){0.f, 0.f, 0.f, 0.f};
#pragma unroll
        for (int ai = 0; ai < 2; ++ai)
#pragma unroll
            for (int m = 0; m < 4; ++m) { bf16_t* rowp = base + (size_t)(row0 + ai * HALF + m * 16) * ldc + col0;
#pragma unroll
                for (int bj = 0; bj < 2; ++bj) { f32x4 v0 = act4<ACT>(acc[ai][bj][m][0] + bv[bj][0]), v1 = act4<ACT>(acc[ai][bj][m][1] + bv[bj][1]);
                    v0 = v0 * sc; v1 = v1 * sc; u32x4 w; w.x = cvt_pk_bf16(v0[0], v0[1]); w.y = cvt_pk_bf16(v0[2], v0[3]); w.z = cvt_pk_bf16(v1[0], v1[1]); w.w = cvt_pk_bf16(v1[2], v1[3]);
                    *(u32x4*)(rowp + bj * HALF) = w; } }
    }
};

struct EpiF32 {
    static constexpr bool PERM = false, AFTER_DRAIN = false;
    float* C; int ldc; const float* bias;
    __device__ __forceinline__ void operator()(const f32x4 (&acc)[2][2][4][2], const Unit& u, int wr, int wc, int fr, int fq) const {
        const int row0 = u.pm * BM + wr * 64 + fr, col0 = u.pn * BM + wc * 32 + 4 * fq;
        f32x4 bv[2][2];
#pragma unroll
        for (int bj = 0; bj < 2; ++bj)
#pragma unroll
            for (int n = 0; n < 2; ++n) bv[bj][n] = bias ? *(const f32x4*)(bias + col0 + bj * HALF + n * 16) : (f32x4){0.f, 0.f, 0.f, 0.f};
#pragma unroll
        for (int ai = 0; ai < 2; ++ai)
#pragma unroll
            for (int m = 0; m < 4; ++m) { float* rowp = C + (size_t)(row0 + ai * HALF + m * 16) * ldc + col0;
#pragma unroll
                for (int bj = 0; bj < 2; ++bj)
#pragma unroll
                    for (int n = 0; n < 2; ++n) *(f32x4*)(rowp + bj * HALF + n * 16) = acc[ai][bj][m][n] + bv[bj][n]; }
    }
};

struct EpiMl {
    static constexpr bool PERM = true, AFTER_DRAIN = false;
    bf16_t* P; float* G; const float* bgate;
    __device__ __forceinline__ void operator()(const f32x4 (&acc)[2][2][4][2], const Unit& u, int wr, int wc, int fr, int fq) const {
        const int row0 = u.pm * BM + wr * 64 + fr;
        if (u.pn < 12) {
            const float sc = (u.pn == 2 || u.pn == 3) ? 0.125f : 1.0f;
            const int col0 = u.pn * BM + wc * 32 + 8 * fq;
#pragma unroll
            for (int ai = 0; ai < 2; ++ai)
#pragma unroll
                for (int m = 0; m < 4; ++m) { bf16_t* rowp = P + (size_t)(row0 + ai * HALF + m * 16) * 3072 + col0;
#pragma unroll
                    for (int bj = 0; bj < 2; ++bj) { const f32x4 v0 = acc[ai][bj][m][0] * sc, v1 = acc[ai][bj][m][1] * sc;
                        u32x4 w; w.x = cvt_pk_bf16(v0[0], v0[1]); w.y = cvt_pk_bf16(v0[2], v0[3]); w.z = cvt_pk_bf16(v1[0], v1[1]); w.w = cvt_pk_bf16(v1[2], v1[3]);
                        *(u32x4*)(rowp + bj * HALF) = w; } }
        } else if (wc == 0) {
            const int col0 = 8 * fq;
            const f32x4 b0 = *(const f32x4*)(bgate + col0), b1 = *(const f32x4*)(bgate + col0 + 4);
#pragma unroll
            for (int ai = 0; ai < 2; ++ai)
#pragma unroll
                for (int m = 0; m < 4; ++m) { float* rowp = G + (size_t)(row0 + ai * HALF + m * 16) * 32 + col0;
                    *(f32x4*)(rowp) = acc[ai][0][m][0] + b0; *(f32x4*)(rowp + 4) = acc[ai][0][m][1] + b1; }
        }
    }
};

template <int ACT, int MODE, bool STATS> struct EpiSwap {
    static constexpr bool PERM = true, AFTER_DRAIN = false;
    bf16_t* VT; const float* bias; float* ST;
    __device__ __forceinline__ void operator()(const f32x4 (&acc)[2][2][4][2], const Unit& u, int wr, int wc, int fr, int fq) const {
        const int ch0 = u.pm * BM + wr * 64 + fr, tok0 = u.pn * BM + wc * 32 + 8 * fq;
#pragma unroll
        for (int bj = 0; bj < 2; ++bj) { const int tok = tok0 + bj * HALF;
            f32x4 s1a = {0.f, 0.f, 0.f, 0.f}, s1b = s1a, s2a = s1a, s2b = s1a;
            size_t tbase;
            if (MODE == 0) tbase = (size_t)(tok >> 7) * (3072 * 128) + (tok & 127);
            else { if (tok < 65536) { const int b_ = tok >> 13, t = tok & 8191; tbase = ((size_t)(b_ * 16) * 128 + (t >> 6)) * 4096 + (t & 63); }
                   else { const int l = tok - 65536; tbase = (size_t)67108864 + (size_t)((l >> 8) * 16) * 16384 + (l & 255); } }
#pragma unroll
            for (int ai = 0; ai < 2; ++ai)
#pragma unroll
                for (int m = 0; m < 4; ++m) { const int ch = ch0 + ai * HALF + m * 16; const float b = bias[ch];
                    const f32x4 v0 = act4<ACT>(acc[ai][bj][m][0] + b), v1 = act4<ACT>(acc[ai][bj][m][1] + b);
                    if (STATS) { s1a += v0; s2a += v0 * v0; s1b += v1; s2b += v1 * v1; }
                    u32x4 w; w.x = cvt_pk_bf16(v0[0], v0[1]); w.y = cvt_pk_bf16(v0[2], v0[3]); w.z = cvt_pk_bf16(v1[0], v1[1]); w.w = cvt_pk_bf16(v1[2], v1[3]);
                    size_t off;
                    if (MODE == 0) off = tbase + (size_t)ch * 128;
                    else { const int head = ch >> 6, d = ch & 63; off = tbase + ((tok < 65536) ? ((size_t)head * 128 * 4096 + (size_t)d * 64) : ((size_t)head * 16384 + (size_t)d * 256)); }
                    *(u32x4*)(VT + off) = w; }
            if (STATS) {
#pragma unroll
                for (int e = 0; e < 4; ++e) { float a0 = s1a[e], q0 = s2a[e], a1 = s1b[e], q1 = s2b[e];
#pragma unroll
                    for (int o = 1; o < 16; o <<= 1) { a0 += __shfl_xor(a0, o); q0 += __shfl_xor(q0, o); a1 += __shfl_xor(a1, o); q1 += __shfl_xor(q1, o); }
                    if (fr == 0) { typedef float f32x2v __attribute__((ext_vector_type(2)));
                        *(f32x2v*)(ST + ((size_t)(tok + e) * 24 + u.pm * 2 + wr) * 2) = (f32x2v){a0, q0};
                        *(f32x2v*)(ST + ((size_t)(tok + 4 + e) * 24 + u.pm * 2 + wr) * 2) = (f32x2v){a1, q1}; } }
            }
        }
    }
};
template <class Epi, class Sched, bool ALIGN_EPI = false, bool SP2 = false>
__device__ __forceinline__ void gemm_phase(PG8_LAS unsigned char* lds, const Gemm g, const Sched& S, const Epi& E) {
    int tid_ = threadIdx.x; asm volatile("" : "+v"(tid_));
    const int tid = tid_, wid = __builtin_amdgcn_readfirstlane(tid >> 6), lane = tid & 63, wr = wid >> 2, wc = wid & 3, fr = lane & 15, fq = lane >> 4;
    const int K = g.K, nt = K / BK;
    unsigned voffA[2], voffB[2];
#pragma unroll
    for (int i = 0; i < 2; ++i) { int R, C; stage_rc(tid * 16 + i * 8192, R, C); const int Rb = Epi::PERM ? ((R & ~31) + perm32(R & 31)) : R;
        voffA[i] = (unsigned)(R * K + C) * 2u; voffB[i] = (unsigned)(Rb * K + C) * 2u; }
    const size_t kstep = (size_t)(BK * 2);
    const size_t hstep = (size_t)HALF * K * 2;
    const size_t tstep = 2 * hstep;
    const unsigned ldsw = (unsigned)wid * 1024u;
    const int aoff = lds_byte(wr * 64 + fr, fq * 8), boff = lds_byte(wc * 32 + fr, fq * 8);
#define PG8_SA(b, h) (((b) * 2 + (h)) * HTB)
#define PG8_SB(b, h) ((4 + (b) * 2 + (h)) * HTB)
#define PG8_STAGE(bufoff, gbase, voff) do { _Pragma("unroll") for (int _i = 0; _i < 2; ++_i) \
        __builtin_amdgcn_global_load_lds((const unsigned*)((const char*)(gbase) + (voff)[_i]), (PG8_LAS unsigned*)(lds + (bufoff) + ldsw + _i * 8192), 16, 0, 0); } while (0)
#define PG8_LDA(dst, b, h) do { _Pragma("unroll") for (int m = 0; m < 4; ++m) _Pragma("unroll") for (int k = 0; k < 2; ++k) dst[m][k] = *(const PG8_LAS bf16x8*)(lds + PG8_SA(b, h) + aoff + m * 2048 + k * 1024); } while (0)
#define PG8_LDB(dst, b, h) do { _Pragma("unroll") for (int n = 0; n < 2; ++n) _Pragma("unroll") for (int k = 0; k < 2; ++k) dst[n][k] = *(const PG8_LAS bf16x8*)(lds + PG8_SB(b, h) + boff + n * 2048 + k * 1024); } while (0)
#define PG8_MMA(ai, bj, At, Bt) do { __builtin_amdgcn_s_setprio(1); _Pragma("unroll") for (int m = 0; m < 4; ++m) _Pragma("unroll") for (int n = 0; n < 2; ++n) _Pragma("unroll") for (int k = 0; k < 2; ++k) \
        acc[ai][bj][m][n] = __builtin_amdgcn_mfma_f32_16x16x32_bf16(Bt[n][k], At[m][k], acc[ai][bj][m][n], 0, 0, 0); __builtin_amdgcn_s_setprio(0); } while (0)
#define PG8_WAIT_V(n) asm volatile("s_waitcnt vmcnt(" #n ")" ::: "memory")
#define PG8_WAIT_L(n) asm volatile("s_waitcnt lgkmcnt(" #n ")" ::: "memory")
#define PG8_BAR __builtin_amdgcn_s_barrier()
#define PG8_SCHED __builtin_amdgcn_sched_barrier(0)
    Unit cur, nxt; int ui = 0;
    if (!S.next(0, cur)) return;
    f32x4 acc[2][2][4][2];
#pragma unroll
    for (int a = 0; a < 2; ++a)
#pragma unroll
        for (int b = 0; b < 2; ++b)
#pragma unroll
            for (int m = 0; m < 4; ++m)
#pragma unroll
                for (int n = 0; n < 2; ++n) acc[a][b][m][n] = (f32x4){0.f, 0.f, 0.f, 0.f};
    bf16x8 At[4][2], B0[2][2], B1[2][2];
    const char* cA = (const char*)g.A + (size_t)cur.pm * tstep; const char* cB = (const char*)g.Bt + (size_t)cur.pn * tstep;
    S.a_ready(cur);
    if constexpr (SP2) {
        PG8_STAGE(PG8_SB(0, 0), cB, voffB); PG8_STAGE(PG8_SB(0, 1), cB + hstep, voffB); PG8_STAGE(PG8_SA(0, 0), cA, voffA); PG8_STAGE(PG8_SA(0, 1), cA + hstep, voffA);
        if (wr == 1) PG8_BAR;
        PG8_WAIT_V(2); PG8_BAR;
        PG8_STAGE(PG8_SB(1, 0), cB + kstep, voffB); PG8_STAGE(PG8_SA(1, 0), cA + kstep, voffA); PG8_STAGE(PG8_SB(1, 1), cB + hstep + kstep, voffB);
        PG8_WAIT_V(6); PG8_BAR;
    } else {
        PG8_STAGE(PG8_SB(0, 0), cB, voffB); PG8_STAGE(PG8_SA(0, 0), cA, voffA); PG8_STAGE(PG8_SB(0, 1), cB + hstep, voffB); PG8_STAGE(PG8_SA(0, 1), cA + hstep, voffA);
        if (wr == 1) PG8_BAR;
        PG8_WAIT_V(4); PG8_BAR;
        PG8_STAGE(PG8_SB(1, 0), cB + kstep, voffB); PG8_STAGE(PG8_SA(1, 0), cA + kstep, voffA); PG8_STAGE(PG8_SB(1, 1), cB + hstep + kstep, voffB);
        PG8_WAIT_V(6); PG8_BAR;
    }
    for (;;) {
        const bool has_next = S.next(ui + 1, nxt);
        const char* nA = has_next ? (const char*)g.A + (size_t)nxt.pm * tstep : cA; const char* nB = has_next ? (const char*)g.Bt + (size_t)nxt.pn * tstep : cB;
        for (int t = 0; t < nt; t += 2) {
            const bool last = (t == nt - 2);
            const char* a1 = cA + (size_t)(t + 1) * kstep;
            const char* a2 = last ? nA : cA + (size_t)(t + 2) * kstep; const char* b2 = last ? nB : cB + (size_t)(t + 2) * kstep;
            const char* a3 = a2 + kstep; const char* b3 = b2 + kstep;
            if (last && has_next) S.a_ready(nxt);
            if constexpr (SP2) {
            PG8_LDB(B0, 0, 0); PG8_LDB(B1, 0, 1); PG8_SCHED; PG8_LDA(At, 0, 0); PG8_STAGE(PG8_SA(1, 1), a1 + hstep, voffA);
            PG8_WAIT_V(8); PG8_WAIT_L(0); PG8_BAR; PG8_MMA(0, 0, At, B0); PG8_MMA(0, 1, At, B1); PG8_BAR; PG8_SCHED;
            PG8_LDA(At, 0, 1); PG8_STAGE(PG8_SB(0, 0), b2, voffB); PG8_STAGE(PG8_SB(0, 1), b2 + hstep, voffB); PG8_STAGE(PG8_SA(0, 0), a2, voffA);
            PG8_WAIT_V(8); PG8_WAIT_L(0); PG8_BAR; PG8_MMA(1, 0, At, B0); PG8_MMA(1, 1, At, B1); PG8_BAR; PG8_SCHED;
            PG8_LDB(B0, 1, 0); PG8_LDB(B1, 1, 1); PG8_SCHED; PG8_LDA(At, 1, 0); PG8_STAGE(PG8_SA(0, 1), a2 + hstep, voffA);
            PG8_WAIT_V(8); PG8_WAIT_L(0); PG8_BAR; PG8_MMA(0, 0, At, B0); PG8_MMA(0, 1, At, B1); PG8_BAR; PG8_SCHED;
            PG8_LDA(At, 1, 1); PG8_STAGE(PG8_SB(1, 0), b3, voffB); PG8_STAGE(PG8_SB(1, 1), b3 + hstep, voffB); PG8_STAGE(PG8_SA(1, 0), a3, voffA);
            PG8_WAIT_V(8); PG8_WAIT_L(0); PG8_BAR; PG8_MMA(1, 0, At, B0); PG8_MMA(1, 1, At, B1); PG8_BAR; PG8_SCHED;
            } else {
            PG8_LDB(B0, 0, 0); PG8_SCHED; PG8_LDA(At, 0, 0); PG8_STAGE(PG8_SA(1, 1), a1 + hstep, voffA);
            PG8_WAIT_L(8); PG8_BAR; PG8_WAIT_L(0); PG8_MMA(0, 0, At, B0); PG8_BAR; PG8_SCHED;
            PG8_LDB(B1, 0, 1); PG8_STAGE(PG8_SB(0, 0), b2, voffB);
            PG8_BAR; PG8_WAIT_L(0); PG8_MMA(0, 1, At, B1); PG8_BAR;
            PG8_LDA(At, 0, 1); PG8_STAGE(PG8_SA(0, 0), a2, voffA);
            PG8_BAR; PG8_WAIT_L(0); PG8_MMA(1, 0, At, B0); PG8_BAR; PG8_SCHED;
            PG8_STAGE(PG8_SB(0, 1), b2 + hstep, voffB);
            PG8_WAIT_V(6); PG8_BAR; PG8_MMA(1, 1, At, B1); PG8_BAR;
            PG8_LDB(B0, 1, 0); PG8_SCHED; PG8_LDA(At, 1, 0); PG8_STAGE(PG8_SA(0, 1), a2 + hstep, voffA);
            PG8_WAIT_L(8); PG8_BAR; PG8_WAIT_L(0); PG8_MMA(0, 0, At, B0); PG8_BAR; PG8_SCHED;
            PG8_LDB(B1, 1, 1); PG8_STAGE(PG8_SB(1, 0), b3, voffB);
            PG8_BAR; PG8_WAIT_L(0); PG8_MMA(0, 1, At, B1); PG8_BAR;
            PG8_LDA(At, 1, 1); PG8_STAGE(PG8_SA(1, 0), a3, voffA);
            PG8_BAR; PG8_WAIT_L(0); PG8_MMA(1, 0, At, B0); PG8_BAR; PG8_SCHED;
            PG8_STAGE(PG8_SB(1, 1), b3 + hstep, voffB);
            PG8_WAIT_V(6); PG8_BAR; PG8_MMA(1, 1, At, B1); PG8_BAR;
            }
        }
        if constexpr (ALIGN_EPI) { if (wr == 0) PG8_BAR; }
        if constexpr (!Epi::AFTER_DRAIN) { E(acc, cur, wr, wc, fr, fq); S.done(cur); }
        if (!has_next) break;
#pragma unroll
        for (int a = 0; a < 2; ++a)
#pragma unroll
            for (int b = 0; b < 2; ++b)
#pragma unroll
                for (int m = 0; m < 4; ++m)
#pragma unroll
                    for (int n = 0; n < 2; ++n) acc[a][b][m][n] = (f32x4){0.f, 0.f, 0.f, 0.f};
        cur = nxt; cA = nA; cB = nB; ++ui;
        if constexpr (ALIGN_EPI) { if (wr == 1) PG8_BAR; }
    }
    PG8_WAIT_V(0);
    if constexpr (!ALIGN_EPI) { if (wr == 0) PG8_BAR; }
    PG8_BAR;
    if constexpr (Epi::AFTER_DRAIN) { E.fused(acc, cur, wr, wc, fr, fq, lds, wid, lane); S.done(cur); }
#undef PG8_SA
#undef PG8_SB
#undef PG8_STAGE
#undef PG8_LDA
#undef PG8_LDB
#undef PG8_MMA
#undef PG8_WAIT_V
#undef PG8_WAIT_L
#undef PG8_BAR
#undef PG8_SCHED
}
}

constexpr int D = 1024, NBATCH = 8, SEQ = 8192, CTXL = 256, DEPTH = 4, FF = 4096, GH = 3072;
constexpr int TLAT = NBATCH * SEQ, TCTX = NBATCH * CTXL, TT = TLAT + TCTX;
constexpr float NORM_EPS = 1e-6f;
constexpr int NWAVES = 8, NTHREADS = 512;

constexpr size_t MiB = 1u << 20;
constexpr size_t WS_CTL = 0, CTL_ZERO_BYTES = 64 * 1024;
constexpr size_t WS_MODS = 1 * MiB;
constexpr size_t WS_ROPE = 2 * MiB;
constexpr size_t WS_XC = 3 * MiB;
constexpr size_t WS_WA = 11 * MiB, WS_WB = 45 * MiB;
constexpr size_t WS_STATS = 79 * MiB;
constexpr size_t WS_HBUF = 92 * MiB;
constexpr size_t WS_BIG = 224 * MiB;
constexpr size_t WS_Y = 752 * MiB;
constexpr size_t WS_NEED = 1016 * MiB;
constexpr size_t WS_GM_U = WS_BIG, WS_GM_VT = WS_BIG + 396 * MiB;
constexpr size_t WS_HID = WS_BIG;
constexpr size_t WS_NA_Q = WS_BIG, WS_NA_K = WS_BIG + 132 * MiB, WS_NA_VT = WS_BIG + 264 * MiB, WS_NA_O = WS_BIG + 396 * MiB;
constexpr size_t WS_ML_P = WS_BIG, WS_ML_G = WS_BIG + 396 * MiB, WS_ML_HD = WS_BIG + 405 * MiB;
static_assert(WS_GM_VT + 396 * MiB <= 1016 * MiB && WS_ML_HD + 264 * MiB <= 1016 * MiB && WS_HID + 528 * MiB <= WS_Y, "ws map");
constexpr size_t WO_GM_IN = 0, WO_GM_OUT = (size_t)6144 * 1024, WO_GM_W1 = WO_GM_OUT + (size_t)1024 * 3072, WO_GM_W2 = WO_GM_W1 + (size_t)4096 * 1024;
constexpr size_t WO_NA_QKV = 0, WO_NA_O = (size_t)3072 * 1024, WO_NA_W1 = WO_NA_O + (size_t)1024 * 1024, WO_NA_W2 = WO_NA_W1 + (size_t)4096 * 1024;
constexpr size_t WO_ML_IN = 0, WO_ML_OUT = (size_t)3328 * 1024, WO_ML_W1 = WO_ML_OUT + (size_t)1024 * 1024, WO_ML_W2 = WO_ML_W1 + (size_t)4096 * 1024;
static_assert((WO_GM_W2 + (size_t)4096 * 1024) * 2 <= 34 * MiB, "weight region");
constexpr int CW_BAR = 1024;

constexpr int RING_OFF = 0, RING_BYTES = 131072;
constexpr int LDSCTL_OFF = RING_BYTES, MISC_OFF = LDSCTL_OFF + 320;
constexpr int LDS_BYTES = 147456;

#define GAS __attribute__((address_space(1)))
#define LAS __attribute__((address_space(3)))
typedef unsigned short bf16;
typedef unsigned v4u __attribute__((ext_vector_type(4)));
typedef unsigned v2u __attribute__((ext_vector_type(2)));
typedef float f32x4 __attribute__((ext_vector_type(4)));
typedef float f32x2 __attribute__((ext_vector_type(2)));
typedef short bf16x8 __attribute__((ext_vector_type(8)));
#define LDS_WAIT() asm volatile("s_waitcnt lgkmcnt(0)" ::: "memory")
#define VM_WAIT() asm volatile("s_waitcnt vmcnt(0)" ::: "memory")
__device__ __forceinline__ unsigned f2bf(float f) { unsigned u = __builtin_bit_cast(unsigned, f); return (u + 0x7fffu + ((u >> 16) & 1u)) >> 16; }
__device__ __forceinline__ unsigned pk2(float lo, float hi) { return f2bf(lo) | (f2bf(hi) << 16); }
__device__ __forceinline__ float bflo(unsigned w) { return __builtin_bit_cast(float, w << 16); }
__device__ __forceinline__ float bfhi(unsigned w) { return __builtin_bit_cast(float, w & 0xffff0000u); }
__device__ __forceinline__ float fexp(float x) { return __builtin_amdgcn_exp2f(x * 1.4426950408889634f); }
#define MFMA16(a, b, c) __builtin_amdgcn_mfma_f32_16x16x32_bf16((a), (b), (c), 0, 0, 0)
#define XB_TMO      128
#define XB_XCNT(j)  (256  + 64 * (j))
#define XB_XSUB(j)  (1280 + 64 * (j))
#define XB_XGEN(j)  (2304 + 64 * (j))
#define XB_TOP      3328
#define XB_TOPGEN   3392
#define XCD_BAR_WORDS 3456
#define XB_SPIN_CAP (1u << 18)

__device__ __forceinline__ unsigned xb_ld(unsigned* p)              { return __hip_atomic_load(p, __ATOMIC_RELAXED, __HIP_MEMORY_SCOPE_AGENT); }
__device__ __forceinline__ unsigned xb_add(unsigned* p, unsigned v) { return __hip_atomic_fetch_add(p, v, __ATOMIC_RELAXED, __HIP_MEMORY_SCOPE_AGENT); }
__device__ __forceinline__ unsigned xb_xcc_id() { return (unsigned)__builtin_amdgcn_s_getreg((3 << 11) | 20) & 0xFu; }
#define XB_SPIN(cond, bar) do { unsigned _sp = 0; while (cond) { __builtin_amdgcn_s_sleep(1); \
    if ((++_sp & 255u) == 0u) { if (xb_ld(&(bar)[XB_TMO])) break; if (_sp > XB_SPIN_CAP) { atomicAdd(&(bar)[XB_TMO], 1u); break; } } } } while (0)

struct XcdBarrier {
    unsigned* bar; unsigned x;
    volatile LAS unsigned* st;
};

__device__ __forceinline__ XcdBarrier xcd_barrier_post(unsigned* bar, volatile LAS unsigned* st) {
    XcdBarrier b; b.bar = bar; b.x = xb_xcc_id(); b.st = st;
    if (threadIdx.x == 0) (void)xb_add(&bar[XB_XCNT(b.x)], 1u);
    return b;
}
__device__ __forceinline__ void xcd_barrier_complete(unsigned* bar, unsigned x, unsigned& nloc, unsigned& nx) {
    const unsigned G = gridDim.x * gridDim.y * gridDim.z;
    unsigned sum, cnt, mine, sp = 0u;
    for (;;) {
        sum = 0u; cnt = 0u; mine = 0u;
#pragma unroll
        for (unsigned j = 0; j < 16; ++j) { const unsigned c = xb_ld(&bar[XB_XCNT(j)]); sum += c; cnt += (c > 0u) ? 1u : 0u; mine = (j == x) ? c : mine; }
        if (sum == G) break;
        __builtin_amdgcn_s_sleep(1);
        if ((++sp & 255u) == 0u) { if (xb_ld(&bar[XB_TMO])) break; if (sp > XB_SPIN_CAP) { atomicAdd(&bar[XB_TMO], 1u); break; } }
    }
    nloc = mine > 0u ? mine : 1u; nx = cnt > 0u ? cnt : 1u;
}

__device__ __forceinline__ void xcd_barrier(const XcdBarrier& b) {
    asm volatile("s_waitcnt vmcnt(0)" ::: "memory");
    __syncthreads();
    if (threadIdx.x == 0) {
        unsigned* bar = b.bar;
        __builtin_amdgcn_s_waitcnt(0);
        unsigned nloc = b.st[0], nx = b.st[1];
        if (nloc == 0u) { xcd_barrier_complete(bar, b.x, nloc, nx); b.st[0] = nloc; b.st[1] = nx; }
        const unsigned old = xb_add(&bar[XB_XSUB(b.x)], 1u);
        const unsigned gen = old / nloc;
        if (old + 1u == (gen + 1u) * nloc) {
            __builtin_amdgcn_fence(__ATOMIC_RELEASE, "agent");
            asm volatile("s_waitcnt vmcnt(0)" ::: "memory");
            const unsigned og = xb_add(&bar[XB_TOP], 1u);
            const unsigned tg = og / nx;
            if (og + 1u == (tg + 1u) * nx) xb_add(&bar[XB_TOPGEN], 1u);
            else XB_SPIN(xb_ld(&bar[XB_TOPGEN]) == tg, bar);
            __builtin_amdgcn_fence(__ATOMIC_ACQUIRE, "agent");
            xb_add(&bar[XB_XGEN(b.x)], 1u);
            asm volatile("s_waitcnt vmcnt(0)" ::: "memory");
        } else {
            XB_SPIN(xb_ld(&bar[XB_XGEN(b.x)]) == gen, bar);
            __builtin_amdgcn_fence(__ATOMIC_ACQUIRE, "agent");
            asm volatile("s_waitcnt vmcnt(0)" ::: "memory");
        }
    }
    __syncthreads();
}

struct Frame {
    LAS unsigned char* lds;
    int tid, lane, wave, G, gw, NGW;
    const float* in[25];
    float* out; unsigned char* ws;
};
__device__ __forceinline__ float wave_sum(float v) {
#pragma unroll
    for (int o = 1; o < 64; o <<= 1) v += __shfl_xor(v, o);
    return v;
}
__device__ __forceinline__ void transpose_item(const float* W, int K, int N, bf16* WT, LAS float* scr, int item, int lane) {
    const int nblk = N / 32, kb = item / nblk, nb = item % nblk, k0 = 64 * kb, n0 = 32 * nb;
#pragma unroll 8
    for (int i = 0; i < 32; ++i) { const int kk = 2 * i + (lane >> 5); scr[kk * 33 + (lane & 31)] = W[(size_t)(k0 + kk) * N + n0 + (lane & 31)]; }
    LDS_WAIT(); asm volatile("" ::: "memory");
    const int c = lane & 7;
#pragma unroll
    for (int j = 0; j < 4; ++j) { const int n = (lane >> 3) + 8 * j; const LAS float* s = scr + (8 * c) * 33 + n;
        v4u o; o.x = pk2(s[0 * 33], s[1 * 33]); o.y = pk2(s[2 * 33], s[3 * 33]); o.z = pk2(s[4 * 33], s[5 * 33]); o.w = pk2(s[6 * 33], s[7 * 33]);
        *(v4u*)(WT + (size_t)(n0 + n) * K + k0 + 8 * c) = o; }
    LDS_WAIT(); asm volatile("" ::: "memory");
}
__device__ __forceinline__ void convert_layer(const Frame& F0, int layer, bf16* WR) {
    Frame F = F0; asm volatile("" : "+v"(F.tid)); F.lane = F.tid & 63;
    LAS float* scr = (LAS float*)(F.lds + RING_OFF + F.wave * 16384);
    const int kind = layer % 3, j = layer / 3;
    const float *W0, *W1; int N0, K1; size_t o1, o2, o3;
    if (kind == 0) { W0 = F.in[9] + (size_t)j * 1024 * 6144; N0 = 6144; W1 = F.in[14] + (size_t)j * 3072 * 1024; K1 = 3072; o1 = WO_GM_OUT; o2 = WO_GM_W1; o3 = WO_GM_W2; }
    else if (kind == 1) { W0 = F.in[15]; N0 = 3072; W1 = F.in[18]; K1 = 1024; o1 = WO_NA_O; o2 = WO_NA_W1; o3 = WO_NA_W2; }
    else { W0 = F.in[20]; N0 = 3072; W1 = F.in[24]; K1 = 1024; o1 = WO_ML_OUT; o2 = WO_ML_W1; o3 = WO_ML_W2; }
    const float* W2 = F.in[7] + (size_t)layer * 1024 * 4096; const float* W3 = F.in[8] + (size_t)layer * 4096 * 1024;
    const int I0 = 16 * (N0 / 32), I1 = (K1 / 64) * 32, I2 = 16 * 128, I3 = 64 * 32;
    for (int it = F.gw; it < I0 + I1 + I2 + I3; it += F.NGW) {
        int r = it;
        if (r < I0) { transpose_item(W0, 1024, N0, WR, scr, r, F.lane); continue; } r -= I0;
        if (r < I1) { transpose_item(W1, K1, 1024, WR + o1, scr, r, F.lane); continue; } r -= I1;
        if (r < I2) { transpose_item(W2, 1024, 4096, WR + o2, scr, r, F.lane); continue; } r -= I2;
        transpose_item(W3, 4096, 1024, WR + o3, scr, r, F.lane);
    }
    if (kind == 2) {
        const float* wg = F.in[21];
        bf16* ext = WR + (size_t)3072 * 1024;
        for (int i = F.gw * 64 + F.lane; i < 256 * 1024; i += F.NGW * 64) { const int rr = i >> 10, d = i & 1023;
            float v = 0.f; if (rr < 32) v = wg[((size_t)(rr >> 4) * 1024 + d) * 16 + (rr & 15)];
            ext[i] = (bf16)f2bf(v); }
    }
}
__device__ __forceinline__ void mods_phase(const Frame& F0) {
    Frame F = F0; asm volatile("" : "+v"(F.tid)); F.lane = F.tid & 63;
    LAS float* cact = (LAS float*)(F.lds);
    LAS float* red = (LAS float*)(F.lds + 9 * 4096);
    float* MODS = (float*)(F.ws + WS_MODS);
    const float* c = F.in[1]; const float* cc = F.in[3];
    for (int i = F.tid; i < 9 * 1024; i += NTHREADS) { const float v = i < 8192 ? c[i] : cc[i - 8192]; cact[i] = v / (1.0f + __expf(-v)); }
    __syncthreads();
    for (int item = blockIdx.x; item < DEPTH * 96; item += F.G) {
        const int layer = item / 96, cb = item % 96, col = cb * 64 + F.lane;
        const float* W = F.in[4] + (size_t)layer * 1024 * 6144 + col;
        float a[9];
#pragma unroll
        for (int m = 0; m < 9; ++m) a[m] = 0.f;
        const int k0 = F.wave * 128;
#pragma unroll 4
        for (int k = k0; k < k0 + 128; ++k) { const float w = W[(size_t)k * 6144];
#pragma unroll
            for (int m = 0; m < 9; ++m) a[m] += cact[m * 1024 + k] * w; }
#pragma unroll
        for (int m = 0; m < 9; ++m) red[(F.wave * 9 + m) * 64 + F.lane] = a[m];
        __syncthreads();
        for (int i = F.tid; i < 9 * 64; i += NTHREADS) { const int m = i >> 6, l = i & 63; float s = 0.f;
#pragma unroll
            for (int w = 0; w < 8; ++w) s += red[(w * 9 + m) * 64 + l];
            MODS[((size_t)layer * 9 + m) * 6144 + cb * 64 + l] = s + F.in[5][(size_t)layer * 6144 + cb * 64 + l]; }
        __syncthreads();
    }
    float* ROPE = (float*)(F.ws + WS_ROPE);
    for (int i = blockIdx.x * NTHREADS + F.tid; i < 2048; i += F.G * NTHREADS) { const int pos = i >> 4, fi = i & 15;
        const float inv = exp2f(-(float)fi * (13.287712379549449f / 16.0f)); const float ang = (float)pos * inv;
        ROPE[i] = cosf(ang); ROPE[2048 + i] = sinf(ang); }
}
template <bool HAS_Y, bool HAS_H>
__device__ __forceinline__ void row_phase(const Frame& F0, int M, const float* src_lat, const float* src_ctx, float* dst_lat, float* dst_ctx,
                                          const float* Y, const float* gy, const float* mod_gate  ,
                                          const float* gh, const float* mod_scale, const float* mod_shift, bf16* H) {
    Frame F = F0; asm volatile("" : "+v"(F.tid)); F.lane = F.tid & 63;
    for (int r = F.gw; r < M; r += F.NGW) {
        const int mb = r < TLAT ? (r >> 13) : 8;
        const float* xs = r < TLAT ? src_lat + (size_t)r * D : src_ctx + (size_t)(r - TLAT) * D;
        f32x4 x[4];
#pragma unroll
        for (int j = 0; j < 4; ++j) x[j] = *(const f32x4*)(xs + 4 * F.lane + 256 * j);
        if (HAS_Y) {
            const float* yr = Y + (size_t)r * D; f32x4 y[4]; float ss = 0.f;
#pragma unroll
            for (int j = 0; j < 4; ++j) { y[j] = *(const f32x4*)(yr + 4 * F.lane + 256 * j); ss += (y[j][0] * y[j][0] + y[j][1] * y[j][1]) + (y[j][2] * y[j][2] + y[j][3] * y[j][3]); }
            const float rs = 1.0f / sqrtf(wave_sum(ss) * (1.0f / D) + NORM_EPS);
            float* xd = r < TLAT ? dst_lat + (size_t)r * D : dst_ctx + (size_t)(r - TLAT) * D;
#pragma unroll
            for (int j = 0; j < 4; ++j) { const int c = 4 * F.lane + 256 * j; const f32x4 g = *(const f32x4*)(gy + c), gt = *(const f32x4*)(mod_gate + (size_t)mb * 6144 + c);
                x[j] = x[j] + gt * (y[j] * rs * g); *(f32x4*)(xd + c) = x[j]; }
        }
        if (HAS_H) {
            float ss = 0.f;
#pragma unroll
            for (int j = 0; j < 4; ++j) ss += (x[j][0] * x[j][0] + x[j][1] * x[j][1]) + (x[j][2] * x[j][2] + x[j][3] * x[j][3]);
            const float rs = 1.0f / sqrtf(wave_sum(ss) * (1.0f / D) + NORM_EPS);
#pragma unroll
            for (int j = 0; j < 4; ++j) { const int c = 4 * F.lane + 256 * j; const f32x4 g = *(const f32x4*)(gh + c), sc = *(const f32x4*)(mod_scale + (size_t)mb * 6144 + c), sh = *(const f32x4*)(mod_shift + (size_t)mb * 6144 + c);
                const f32x4 h = x[j] * rs * g * (sc + 1.0f) + sh; v2u w; w.x = pk2(h[0], h[1]); w.y = pk2(h[2], h[3]); *(v2u*)(H + (size_t)r * D + c) = w; }
        }
    }
}

__device__ __forceinline__ void mix_phase(const Frame& F0, int nchunks, const bf16* VT, bf16* U, const float* ST, const float* Wsp, const float* bsp, const float* lng) {
    Frame F = F0; asm volatile("" : "+v"(F.tid)); F.lane = F.tid & 63;
    constexpr int WPS = 136;
    LAS bf16* Wp = (LAS bf16*)(F.lds);
    LAS float* rq = (LAS float*)(F.lds + 128 * WPS * 2);
    LAS float* mu = rq + 128; LAS float* mm = mu + 128; LAS float* bsv = mm + 128; LAS float* gam = bsv + 128;
    const int fr = F.lane & 15, fq = F.lane >> 4;
    for (int unit = blockIdx.x; unit < nchunks * 8; unit += F.G) {
        const int chunk = unit >> 3, g = unit & 7;
        if (F.tid < 128) { const int tok = chunk * 128 + F.tid; float s = 0.f, q = 0.f;
#pragma unroll 8
            for (int sl = 0; sl < 24; ++sl) { const f32x2 p = *(const f32x2*)(ST + ((size_t)tok * 24 + sl) * 2); s += p[0]; q += p[1]; }
            const float mean = s * (1.0f / GH), var = fmaxf(q * (1.0f / GH) - mean * mean, 0.f);
            rq[F.tid] = 1.0f / sqrtf(var + NORM_EPS); mu[F.tid] = mean; bsv[F.tid] = bsp[g * 128 + F.tid];
        } else gam[F.tid - 128] = lng[g * 384 + F.tid - 128];
        __syncthreads();
        { const int p = F.tid >> 2, qs = (F.tid & 3) * 32; const float* wrow = Wsp + ((size_t)g * 128 + p) * 128 + qs; float macc = 0.f;
#pragma unroll
          for (int i = 0; i < 4; ++i) { const f32x4 w0 = *(const f32x4*)(wrow + 8 * i), w1 = *(const f32x4*)(wrow + 8 * i + 4); unsigned pk[4];
#pragma unroll
              for (int e = 0; e < 4; ++e) { const int q0 = qs + 8 * i + 2 * e; const float a = (e < 2 ? w0[2 * e] : w1[2 * e - 4]) * rq[q0], b = (e < 2 ? w0[2 * e + 1] : w1[2 * e - 3]) * rq[q0 + 1];
                  const unsigned w = pk2(a, b); pk[e] = w; macc += bflo(w) * mu[q0] + bfhi(w) * mu[q0 + 1]; }
              *(LAS v4u*)(Wp + p * WPS + qs + 8 * i) = (v4u){pk[0], pk[1], pk[2], pk[3]}; }
          macc += __shfl_xor(macc, 1); macc += __shfl_xor(macc, 2);
          if ((F.tid & 3) == 0) mm[p] = macc; }
        __syncthreads();
        const int c0 = F.wave * 48;
        f32x4 acc[3][8];
#pragma unroll
        for (int ct = 0; ct < 3; ++ct)
#pragma unroll
            for (int pt = 0; pt < 8; ++pt) acc[ct][pt] = (f32x4){0.f, 0.f, 0.f, 0.f};
        const bf16* vbase = VT + ((size_t)chunk * 3072 + g * 384 + c0 + fr) * 128 + fq * 8;
#pragma unroll
        for (int ks = 0; ks < 4; ++ks) {
            bf16x8 vf[3];
#pragma unroll
            for (int ct = 0; ct < 3; ++ct) vf[ct] = *(const bf16x8*)(vbase + (size_t)ct * 16 * 128 + ks * 32);
#pragma unroll
            for (int pt = 0; pt < 8; ++pt) { const bf16x8 wf = *(const LAS bf16x8*)(Wp + (16 * pt + fr) * WPS + ks * 32 + fq * 8);
#pragma unroll
                for (int ct = 0; ct < 3; ++ct) acc[ct][pt] = MFMA16(vf[ct], wf, acc[ct][pt]); }
        }
#pragma unroll
        for (int pt = 0; pt < 8; ++pt) { const int p = 16 * pt + fr; const float mp = mm[p], bp = bsv[p]; bf16* urow = U + ((size_t)chunk * 128 + p) * GH + g * 384;
#pragma unroll
            for (int ct = 0; ct < 3; ++ct) { const int c = c0 + 16 * ct + 4 * fq; const v2u uu = *(const v2u*)(urow + c);
                const float o0 = bflo(uu.x) * (gam[c] * (acc[ct][pt][0] - mp) + bp), o1 = bfhi(uu.x) * (gam[c + 1] * (acc[ct][pt][1] - mp) + bp);
                const float o2 = bflo(uu.y) * (gam[c + 2] * (acc[ct][pt][2] - mp) + bp), o3 = bfhi(uu.y) * (gam[c + 3] * (acc[ct][pt][3] - mp) + bp);
                v2u w; w.x = pk2(o0, o1); w.y = pk2(o2, o3); *(v2u*)(urow + c) = w; } }
        __syncthreads();
    }
}

__device__ __forceinline__ void na_phase(const Frame& F0, const bf16* Q, const bf16* Kb, const bf16* VT, bf16* O, const float* rpb) {
    Frame F = F0; asm volatile("" : "+v"(F.tid)); F.lane = F.tid & 63;
    LAS float* rp = (LAS float*)(F.lds);
    const int fr = F.lane & 15, fq = F.lane >> 4;
    const bf16* VTC = VT + (size_t)67108864;
    for (int unit = blockIdx.x; unit < 8192 + 256; unit += F.G) {
        const bool lat = unit < 8192;
        int b, head, r = 0, j = 0, qtok;
        if (lat) { b = unit >> 10; head = (unit >> 6) & 15; r = 2 * (unit & 63) + (F.wave >> 2); j = F.wave & 3; qtok = b * SEQ + r * 64 + 16 * j + fr; }
        else { const int u2 = unit - 8192; b = u2 >> 5; head = (u2 >> 1) & 15; qtok = TLAT + b * CTXL + (u2 & 1) * 128 + F.wave * 16 + fr; }
        for (int i = F.tid; i < 465; i += NTHREADS) rp[i] = rpb[head * 465 + i];
        __syncthreads();
        bf16x8 qf[2];
#pragma unroll
        for (int ks = 0; ks < 2; ++ks) qf[ks] = *(const bf16x8*)(Q + (size_t)qtok * D + head * 64 + ks * 32 + fq * 8);
        const int rs = min(max(r - 4, 0), 120);
        const int kc0 = (j == 0) ? 0 : (j == 1) ? 8 : (j == 2) ? 24 : 32;
        f32x4 s[32];
        if (lat) {
#pragma unroll
            for (int i = 0; i < 8; ++i)
#pragma unroll
                for (int t = 0; t < 2; ++t) { const size_t ktok = (size_t)b * SEQ + (rs + i) * 64 + kc0 + 16 * t + fr; f32x4 a = {0.f, 0.f, 0.f, 0.f};
#pragma unroll
                    for (int ks = 0; ks < 2; ++ks) { const bf16x8 kf = *(const bf16x8*)(Kb + ktok * D + head * 64 + ks * 32 + fq * 8); a = MFMA16(kf, qf[ks], a); }
                    s[i * 2 + t] = a; }
        } else {
#pragma unroll
            for (int t = 0; t < 16; ++t) s[t] = (f32x4){-1e30f, -1e30f, -1e30f, -1e30f};
        }
#pragma unroll
        for (int t = 0; t < 16; ++t) { const size_t ktok = (size_t)TLAT + b * CTXL + 16 * t + fr; f32x4 a = {0.f, 0.f, 0.f, 0.f};
#pragma unroll
            for (int ks = 0; ks < 2; ++ks) { const bf16x8 kf = *(const bf16x8*)(Kb + ktok * D + head * 64 + ks * 32 + fq * 8); a = MFMA16(kf, qf[ks], a); }
            s[16 + t] = a; }
        if (lat) {
            const int qc = 16 * j + fr, wsq = min(max(qc - 8, 0), 48);
#pragma unroll
            for (int t = 0; t < 2; ++t)
#pragma unroll
                for (int e = 0; e < 4; ++e) { const int kc = kc0 + 16 * t + 4 * fq + e; const bool valid = (kc >= wsq) && (kc < wsq + 16); const int dc = min(max(kc - qc, -15), 15) + 15;
#pragma unroll
                    for (int i = 0; i < 8; ++i) { const int drow = rs + i - r + 7; const float bias = rp[drow * 31 + dc]; s[i * 2 + t][e] = valid ? s[i * 2 + t][e] + bias : -1e30f; } }
        }
        float mx = -1e30f;
#pragma unroll
        for (int t = 0; t < 32; ++t) mx = fmaxf(fmaxf(fmaxf(s[t][0], s[t][1]), fmaxf(s[t][2], s[t][3])), mx);
        mx = fmaxf(mx, __shfl_xor(mx, 16)); mx = fmaxf(mx, __shfl_xor(mx, 32));
        float sum = 0.f;
#pragma unroll
        for (int t = 0; t < 32; ++t)
#pragma unroll
            for (int e = 0; e < 4; ++e) { const float p = fexp(s[t][e] - mx); s[t][e] = p; sum += p; }
        sum += __shfl_xor(sum, 16); sum += __shfl_xor(sum, 32);
        f32x4 oacc[4];
#pragma unroll
        for (int dt = 0; dt < 4; ++dt) oacc[dt] = (f32x4){0.f, 0.f, 0.f, 0.f};
        if (lat) {
#pragma unroll
            for (int i = 0; i < 8; ++i) { v4u pw; pw.x = pk2(s[2 * i][0], s[2 * i][1]); pw.y = pk2(s[2 * i][2], s[2 * i][3]); pw.z = pk2(s[2 * i + 1][0], s[2 * i + 1][1]); pw.w = pk2(s[2 * i + 1][2], s[2 * i + 1][3]);
                const bf16x8 pf = __builtin_bit_cast(bf16x8, pw);
                const bf16* vb = VT + (((size_t)(b * 16 + head) * 128 + rs + i) * 64) * 64 + kc0 + 4 * fq;
#pragma unroll
                for (int dt = 0; dt < 4; ++dt) { const v2u lo = *(const v2u*)(vb + (size_t)(16 * dt + fr) * 64), hi = *(const v2u*)(vb + (size_t)(16 * dt + fr) * 64 + 16);
                    const bf16x8 vf = __builtin_bit_cast(bf16x8, ((v4u){lo.x, lo.y, hi.x, hi.y})); oacc[dt] = MFMA16(vf, pf, oacc[dt]); } }
        }
#pragma unroll
        for (int i = 0; i < 8; ++i) { const int t0 = 16 + 2 * i; v4u pw; pw.x = pk2(s[t0][0], s[t0][1]); pw.y = pk2(s[t0][2], s[t0][3]); pw.z = pk2(s[t0 + 1][0], s[t0 + 1][1]); pw.w = pk2(s[t0 + 1][2], s[t0 + 1][3]);
            const bf16x8 pf = __builtin_bit_cast(bf16x8, pw);
            const bf16* vb = VTC + ((size_t)(b * 16 + head) * 64) * 256 + 32 * i + 4 * fq;
#pragma unroll
            for (int dt = 0; dt < 4; ++dt) { const v2u lo = *(const v2u*)(vb + (size_t)(16 * dt + fr) * 256), hi = *(const v2u*)(vb + (size_t)(16 * dt + fr) * 256 + 16);
                const bf16x8 vf = __builtin_bit_cast(bf16x8, ((v4u){lo.x, lo.y, hi.x, hi.y})); oacc[dt] = MFMA16(vf, pf, oacc[dt]); } }
        const float inv = 1.0f / sum;
#pragma unroll
        for (int dt = 0; dt < 4; ++dt) { v2u w; w.x = pk2(oacc[dt][0] * inv, oacc[dt][1] * inv); w.y = pk2(oacc[dt][2] * inv, oacc[dt][3] * inv);
            *(v2u*)(O + (size_t)qtok * D + head * 64 + 16 * dt + 4 * fq) = w; }
        __syncthreads();
    }
}

__device__ __forceinline__ size_t scan_tokbase(int s, int b, int dir) { if (s < 4) return (size_t)TLAT + b * CTXL + (dir ? 3 - s : s) * 64; return (size_t)b * SEQ + (dir ? 127 - (s - 4) : s - 4) * 64; }
__device__ __forceinline__ void scan_phase(const Frame& F0, const bf16* P, const float* Gt, bf16* HD, const float* ROPE) {
    Frame F = F0; asm volatile("" : "+v"(F.tid)); F.lane = F.tid & 63;
    constexpr int LS = 72;
    LAS bf16* Qs = (LAS bf16*)(F.lds);
    LAS bf16* Ks = Qs + 64 * LS;
    LAS bf16* VTs = Ks + 64 * LS;
    LAS bf16* KwT = VTs + 80 * LS;
    LAS bf16* As = KwT + 64 * LS;
    LAS bf16* CT0 = As + 64 * LS;
    LAS bf16* CT1 = CT0 + 80 * LS;
    LAS float* ga = (LAS float*)(CT1 + 80 * LS);
    LAS float* g_u = ga, *g_M = ga + 64, *g_in = ga + 128, *g_em = ga + 192, *g_w = ga + 256, *g_dec = ga + 320;
    const int fr = F.lane & 15, fq = F.lane >> 4;
    const int soff = F.tid >> 3, seg = F.tid & 7;
    for (int unit = blockIdx.x; unit < 256; unit += F.G) {
        const int b = unit >> 5, head = (unit >> 2) & 7, dir = (unit >> 1) & 1, vh = unit & 1;
        for (int i = F.tid; i < 80 * LS; i += NTHREADS) { CT0[i] = 0; if (i >= 64 * LS) VTs[i] = (i < 65 * LS) ? (bf16)0x3F80u : (bf16)0; }
        f32x4 st[3];
#pragma unroll
        for (int x = 0; x < 3; ++x) st[x] = (f32x4){0.f, 0.f, 0.f, 0.f};
        float m_st = 0.f;
        const int tau = dir ? 63 - soff : soff;
        v4u rq_, rk_, rv_; float rgi = 0.f, rgf = 0.f;
        { const size_t tb = scan_tokbase(0, b, dir); const bf16* pr = P + (tb + soff) * 3072;
          rq_ = *(const v4u*)(pr + head * 64 + seg * 8); rk_ = *(const v4u*)(pr + 512 + head * 64 + seg * 8); rv_ = *(const v4u*)(pr + 1024 + head * 128 + vh * 64 + seg * 8);
          if (F.wave == 0) { const size_t tk = tb + (dir ? 63 - F.lane : F.lane); rgi = Gt[tk * 32 + dir * 16 + head]; rgf = Gt[tk * 32 + dir * 16 + 8 + head]; } }
        __syncthreads();
        for (int s = 0; s < 132; ++s) {
            LAS bf16* CTc = (s & 1) ? CT1 : CT0; LAS bf16* CTn = (s & 1) ? CT0 : CT1;
            const bool latent = s >= 4; const int crow = latent ? (dir ? 127 - (s - 4) : s - 4) : 0;
            const size_t tb = scan_tokbase(s, b, dir);
            float kv[8];
            { float qv[8]; const unsigned qw[4] = {rq_.x, rq_.y, rq_.z, rq_.w}, kw[4] = {rk_.x, rk_.y, rk_.z, rk_.w};
#pragma unroll
              for (int e = 0; e < 4; ++e) { qv[2 * e] = bflo(qw[e]); qv[2 * e + 1] = bfhi(qw[e]); kv[2 * e] = bflo(kw[e]); kv[2 * e + 1] = bfhi(kw[e]); }
              if (latent) {
                  const int pos = (seg < 4) ? crow : soff; const float* ct = ROPE + pos * 16 + (seg & 1) * 8; const float sgn = (seg & 2) ? 1.0f : -1.0f;
                  const f32x4 c0 = *(const f32x4*)(ct), c1 = *(const f32x4*)(ct + 4), s0 = *(const f32x4*)(ct + 2048), s1 = *(const f32x4*)(ct + 2052);
#pragma unroll
                  for (int e = 0; e < 8; ++e) { const float cs = e < 4 ? c0[e] : c1[e - 4], sn = (e < 4 ? s0[e] : s1[e - 4]) * sgn;
                      const float qp = __shfl_xor(qv[e], 2), kp = __shfl_xor(kv[e], 2);
                      qv[e] = qv[e] * cs + qp * sn; kv[e] = kv[e] * cs + kp * sn; }
              }
              v4u qo, ko; qo.x = pk2(qv[0], qv[1]); qo.y = pk2(qv[2], qv[3]); qo.z = pk2(qv[4], qv[5]); qo.w = pk2(qv[6], qv[7]);
              ko.x = pk2(kv[0], kv[1]); ko.y = pk2(kv[2], kv[3]); ko.z = pk2(kv[4], kv[5]); ko.w = pk2(kv[6], kv[7]);
              *(LAS v4u*)(Qs + tau * LS + seg * 8) = qo; *(LAS v4u*)(Ks + tau * LS + seg * 8) = ko;
              kv[0] = bflo(ko.x); kv[1] = bfhi(ko.x); kv[2] = bflo(ko.y); kv[3] = bfhi(ko.y); kv[4] = bflo(ko.z); kv[5] = bfhi(ko.z); kv[6] = bflo(ko.w); kv[7] = bfhi(ko.w);
              const unsigned vw[4] = {rv_.x, rv_.y, rv_.z, rv_.w};
#pragma unroll
              for (int e = 0; e < 4; ++e) { VTs[(seg * 8 + 2 * e) * LS + tau] = (bf16)(vw[e] & 0xffffu); VTs[(seg * 8 + 2 * e + 1) * LS + tau] = (bf16)(vw[e] >> 16); }
            }
            if (F.wave == 0) {
                const float lf = fminf(rgf, 0.f) - log1pf(__expf(-fabsf(rgf)));
                float bb = lf;
#pragma unroll
                for (int o = 1; o < 64; o <<= 1) { const float t = __shfl_up(bb, o); if (F.lane >= o) bb += t; }
                const float u = rgi - bb; float cm = u;
#pragma unroll
                for (int o = 1; o < 64; o <<= 1) { const float t = __shfl_up(cm, o); if (F.lane >= o) cm = fmaxf(cm, t); }
                const float M = fmaxf(m_st, cm);
                const float M63 = __shfl(M, 63), bl = __shfl(bb, 63);
                g_u[F.lane] = u; g_M[F.lane] = M; g_in[F.lane] = fexp(m_st - M); g_em[F.lane] = fexp(-bb - M); g_w[F.lane] = fexp(u - M63);
                if (F.lane == 0) g_dec[0] = fexp(m_st - M63);
                m_st = bl + M63;
            }
            __syncthreads();
            { const float w = g_w[tau];
#pragma unroll
              for (int e = 0; e < 8; ++e) KwT[(seg * 8 + e) * LS + tau] = (bf16)f2bf(kv[e] * w); }
            if (s + 1 < 132) { const size_t tn = scan_tokbase(s + 1, b, dir); const bf16* pr = P + (tn + soff) * 3072;
                rq_ = *(const v4u*)(pr + head * 64 + seg * 8); rk_ = *(const v4u*)(pr + 512 + head * 64 + seg * 8); rv_ = *(const v4u*)(pr + 1024 + head * 128 + vh * 64 + seg * 8);
                if (F.wave == 0) { const size_t tk = tn + (dir ? 63 - F.lane : F.lane); rgi = Gt[tk * 32 + dir * 16 + head]; rgf = Gt[tk * 32 + dir * 16 + 8 + head]; } }
            { const int tt = F.wave >> 1;
#pragma unroll
              for (int z = 0; z < 2; ++z) { const int sg = 2 * (F.wave & 1) + z; const int tq = 16 * tt + fr, sg0 = 16 * sg + 4 * fq;
                  v2u w = {0u, 0u};
                  if (sg <= tt) { f32x4 a = {0.f, 0.f, 0.f, 0.f};
#pragma unroll
                      for (int ks = 0; ks < 2; ++ks) { const bf16x8 kf = *(const LAS bf16x8*)(Ks + (16 * sg + fr) * LS + ks * 32 + fq * 8), qf = *(const LAS bf16x8*)(Qs + (16 * tt + fr) * LS + ks * 32 + fq * 8); a = MFMA16(kf, qf, a); }
                      const float Mt = g_M[tq]; float av[4];
#pragma unroll
                      for (int e = 0; e < 4; ++e) { const int sig = sg0 + e; av[e] = (sig <= tq) ? a[e] * fexp(g_u[sig] - Mt) : 0.f; }
                      w.x = pk2(av[0], av[1]); w.y = pk2(av[2], av[3]); }
                  *(LAS v2u*)(As + tq * LS + sg0) = w; } }
            __syncthreads();
            { const int tt = F.wave & 3, eh = F.wave >> 2; const int tq = 16 * tt + fr;
              f32x4 acc[3];
#pragma unroll
              for (int x = 0; x < 3; ++x) acc[x] = (f32x4){0.f, 0.f, 0.f, 0.f};
#pragma unroll
              for (int ks = 0; ks < 2; ++ks) { const bf16x8 qf = *(const LAS bf16x8*)(Qs + tq * LS + ks * 32 + fq * 8);
#pragma unroll
                  for (int x = 0; x < 3; ++x) { const int et = (x < 2) ? 2 * eh + x : 4; const bf16x8 cf = *(const LAS bf16x8*)(CTc + (16 * et + fr) * LS + ks * 32 + fq * 8); acc[x] = MFMA16(cf, qf, acc[x]); } }
              const float it = g_in[tq];
#pragma unroll
              for (int x = 0; x < 3; ++x) acc[x] = acc[x] * it;
#pragma unroll
              for (int ks = 0; ks < 2; ++ks) { const bf16x8 af = *(const LAS bf16x8*)(As + tq * LS + ks * 32 + fq * 8);
#pragma unroll
                  for (int x = 0; x < 3; ++x) { const int et = (x < 2) ? 2 * eh + x : 4; const bf16x8 vf = *(const LAS bf16x8*)(VTs + (16 * et + fr) * LS + ks * 32 + fq * 8); acc[x] = MFMA16(vf, af, acc[x]); } }
              const float den = __shfl(acc[2][0], fr);
              const float rden = 1.0f / fmaxf(fabsf(den), g_em[tq]);
              const int off = dir ? 63 - tq : tq;
              bf16* orow = HD + ((size_t)dir * TT + tb + off) * D + head * 128 + vh * 64 + 4 * fq;
#pragma unroll
              for (int x = 0; x < 2; ++x) { v2u w; w.x = pk2(acc[x][0] * rden, acc[x][1] * rden); w.y = pk2(acc[x][2] * rden, acc[x][3] * rden); *(v2u*)(orow + 16 * (2 * eh + x)) = w; }
            }
            { const int dt = F.wave & 3, eh = F.wave >> 2; const float dec = g_dec[0];
#pragma unroll
              for (int x = 0; x < 3; ++x) { if (x == 2 && eh != 0) continue; const int et = (x < 2) ? 2 * eh + x : 4;
                  st[x] = st[x] * dec;
#pragma unroll
                  for (int ks = 0; ks < 2; ++ks) { const bf16x8 vf = *(const LAS bf16x8*)(VTs + (16 * et + fr) * LS + ks * 32 + fq * 8), kf = *(const LAS bf16x8*)(KwT + (16 * dt + fr) * LS + ks * 32 + fq * 8); st[x] = MFMA16(vf, kf, st[x]); }
#pragma unroll
                  for (int e = 0; e < 4; ++e) CTn[(16 * et + 4 * fq + e) * LS + 16 * dt + fr] = (bf16)f2bf(st[x][e]); } }
            __syncthreads();
        }
    }
}
__device__ __forceinline__ void readout_phase(const Frame& F0, const bf16* HD, const bf16* P, const float* ng, bf16* H) {
    Frame F = F0; asm volatile("" : "+v"(F.tid)); F.lane = F.tid & 63;
    for (int r = F.gw; r < TT; r += F.NGW) {
        const int c = 16 * F.lane;
        const v4u f0 = *(const v4u*)(HD + (size_t)r * D + c), f1 = *(const v4u*)(HD + (size_t)r * D + c + 8);
        const v4u b0 = *(const v4u*)(HD + ((size_t)TT + r) * D + c), b1 = *(const v4u*)(HD + ((size_t)TT + r) * D + c + 8);
        const v4u o0 = *(const v4u*)(P + (size_t)r * 3072 + 2048 + c), o1 = *(const v4u*)(P + (size_t)r * 3072 + 2048 + c + 8);
        const unsigned fw[8] = {f0.x, f0.y, f0.z, f0.w, f1.x, f1.y, f1.z, f1.w}, bw[8] = {b0.x, b0.y, b0.z, b0.w, b1.x, b1.y, b1.z, b1.w}, ow[8] = {o0.x, o0.y, o0.z, o0.w, o1.x, o1.y, o1.z, o1.w};
        float h[16]; float ss = 0.f;
#pragma unroll
        for (int e = 0; e < 8; ++e) { h[2 * e] = bflo(fw[e]) + bflo(bw[e]); h[2 * e + 1] = bfhi(fw[e]) + bfhi(bw[e]); ss += h[2 * e] * h[2 * e] + h[2 * e + 1] * h[2 * e + 1]; }
        ss += __shfl_xor(ss, 1); ss += __shfl_xor(ss, 2); ss += __shfl_xor(ss, 4);
        const float rs = 1.0f / sqrtf(ss * (1.0f / 128.0f) + NORM_EPS);
        unsigned ww[8];
#pragma unroll
        for (int e = 0; e < 8; ++e) { const float oa = bflo(ow[e]), ob = bfhi(ow[e]);
            const float va = h[2 * e] * rs * ng[c + 2 * e] / (1.0f + __expf(-oa)), vb = h[2 * e + 1] * rs * ng[c + 2 * e + 1] / (1.0f + __expf(-ob)); ww[e] = pk2(va, vb); }
        *(v4u*)(H + (size_t)r * D + c) = (v4u){ww[0], ww[1], ww[2], ww[3]}; *(v4u*)(H + (size_t)r * D + c + 8) = (v4u){ww[4], ww[5], ww[6], ww[7]};
    }
}

struct Args { const float* in[25]; float* out; unsigned char* ws; };
__global__ void __launch_bounds__(NTHREADS, 2) fwd_kernel(Args args) {
    extern __shared__ __attribute__((aligned(16))) unsigned char lds_raw[];
    Frame F;
    F.lds = (LAS unsigned char*)lds_raw;
    F.tid = threadIdx.x; F.lane = F.tid & 63; F.wave = __builtin_amdgcn_readfirstlane(F.tid >> 6);
    F.G = gridDim.x; F.gw = blockIdx.x * NWAVES + F.wave; F.NGW = F.G * NWAVES;
#pragma unroll
    for (int i = 0; i < 25; ++i) F.in[i] = args.in[i];
    F.out = args.out; F.ws = args.ws;
    unsigned char* ws = args.ws;
    for (int u = F.tid; u < (LDS_BYTES - LDSCTL_OFF) / 4; u += NTHREADS) ((LAS unsigned*)(F.lds + LDSCTL_OFF))[u] = 0u;
    __syncthreads();
    XcdBarrier bar = xcd_barrier_post((unsigned*)(ws + WS_CTL) + CW_BAR, (volatile LAS unsigned*)(F.lds + MISC_OFF) + 8);
#define GRID_BAR() xcd_barrier(bar)
    float* MODS = (float*)(ws + WS_MODS);
    float* XC = (float*)(ws + WS_XC);
    bf16* WA = (bf16*)(ws + WS_WA); bf16* WB = (bf16*)(ws + WS_WB);
    bf16* HBUF = (bf16*)(ws + WS_HBUF);
    float* Y = (float*)(ws + WS_Y);
    float* ST = (float*)(ws + WS_STATS);
    const float* norm_g = F.in[6];
    LAS unsigned char* ring = F.lds + RING_OFF;

    mods_phase(F);
    convert_layer(F, 0, WA);
    convert_layer(F, 1, WB);
    GRID_BAR();
    row_phase<false, true>(F, TT, F.in[0], F.in[2], nullptr, nullptr, nullptr, nullptr, nullptr, norm_g, MODS + 1024, MODS, HBUF);
    GRID_BAR();

    for (int layer = 0; layer < DEPTH; ++layer) {
        const int kind = layer % 3, j = layer / 3, M = (layer == DEPTH - 1) ? TLAT : TT;
        bf16* WR = (layer & 1) ? WB : WA;
        const float* mods_l = MODS + (size_t)layer * 9 * 6144;
        if (kind == 0) {
            bf16* U = (bf16*)(ws + WS_GM_U); bf16* VT = (bf16*)(ws + WS_GM_VT);
            const float* b_in = F.in[10] + (size_t)j * 6144;
            { pg8::Gemm g{HBUF, WR + WO_GM_IN, M, GH, D}; pg8::StaticOrder S; S.init(M, GH, F.G, (int)blockIdx.x);
              pg8::EpiBf16<1> E{U, GH, b_in, 0, 0, 1.f};
              pg8::gemm_phase<pg8::EpiBf16<1>, pg8::StaticOrder, true, true>(ring, g, S, E); }
            { pg8::Gemm g{WR + WO_GM_IN + (size_t)GH * D, HBUF, GH, M, D}; pg8::StaticOrder S; S.init(GH, M, F.G, (int)blockIdx.x);
              pg8::EpiSwap<1, 0, true> E{VT, b_in + GH, ST};
              pg8::gemm_phase<pg8::EpiSwap<1, 0, true>, pg8::StaticOrder, true, true>(ring, g, S, E); }
            GRID_BAR();
            mix_phase(F, M / 128, VT, U, ST, F.in[12] + (size_t)j * 8 * 128 * 128, F.in[13] + (size_t)j * 8 * 128, F.in[11] + (size_t)j * GH);
            GRID_BAR();
            { pg8::Gemm g{U, WR + WO_GM_OUT, M, D, GH}; pg8::StaticOrder S; S.init(M, D, F.G, (int)blockIdx.x);
              pg8::EpiF32 E{Y, D, nullptr};
              pg8::gemm_phase<pg8::EpiF32, pg8::StaticOrder, true, true>(ring, g, S, E); }
            GRID_BAR();
        } else if (kind == 1) {
            bf16* Q = (bf16*)(ws + WS_NA_Q); bf16* Kb = (bf16*)(ws + WS_NA_K); bf16* VT = (bf16*)(ws + WS_NA_VT); bf16* O = (bf16*)(ws + WS_NA_O);
            const float* b_qkv = F.in[16];
            { pg8::Gemm g{HBUF, WR + WO_NA_QKV, M, 2048, D}; pg8::StaticOrder S; S.init(M, 2048, F.G, (int)blockIdx.x);
              pg8::EpiBf16<0> E{Q, D, b_qkv, 1024, (size_t)(WS_NA_K - WS_NA_Q) / 2, 0.125f};
              pg8::gemm_phase<pg8::EpiBf16<0>, pg8::StaticOrder, true, true>(ring, g, S, E); }
            { pg8::Gemm g{WR + WO_NA_QKV + (size_t)2048 * D, HBUF, D, M, D}; pg8::StaticOrder S; S.init(D, M, F.G, (int)blockIdx.x);
              pg8::EpiSwap<0, 1, false> E{VT, b_qkv + 2048, nullptr};
              pg8::gemm_phase<pg8::EpiSwap<0, 1, false>, pg8::StaticOrder, true, true>(ring, g, S, E); }
            GRID_BAR();
            na_phase(F, Q, Kb, VT, O, F.in[17]);
            GRID_BAR();
            { pg8::Gemm g{O, WR + WO_NA_O, M, D, D}; pg8::StaticOrder S; S.init(M, D, F.G, (int)blockIdx.x);
              pg8::EpiF32 E{Y, D, F.in[19]};
              pg8::gemm_phase<pg8::EpiF32, pg8::StaticOrder, true, true>(ring, g, S, E); }
            GRID_BAR();
        } else {
            bf16* P = (bf16*)(ws + WS_ML_P); float* Gt = (float*)(ws + WS_ML_G); bf16* HD = (bf16*)(ws + WS_ML_HD);
            { pg8::Gemm g{HBUF, WR + WO_ML_IN, M, 3328, D}; pg8::StaticOrder S; S.init(M, 3328, F.G, (int)blockIdx.x);
              pg8::EpiMl E{P, Gt, F.in[22]};
              pg8::gemm_phase<pg8::EpiMl, pg8::StaticOrder, true, true>(ring, g, S, E); }
            GRID_BAR();
            scan_phase(F, P, Gt, HD, (const float*)(ws + WS_ROPE));
            GRID_BAR();
            readout_phase(F, HD, P, F.in[23], HBUF);
            GRID_BAR();
            { pg8::Gemm g{HBUF, WR + WO_ML_OUT, M, D, D}; pg8::StaticOrder S; S.init(M, D, F.G, (int)blockIdx.x);
              pg8::EpiF32 E{Y, D, nullptr};
              pg8::gemm_phase<pg8::EpiF32, pg8::StaticOrder, true, true>(ring, g, S, E); }
            GRID_BAR();
        }
        row_phase<true, true>(F, M, layer == 0 ? F.in[0] : F.out, layer == 0 ? F.in[2] : XC, F.out, XC, Y, norm_g + ((size_t)layer * 4 + 1) * D, mods_l + 2 * 1024,
                              norm_g + ((size_t)layer * 4 + 2) * D, mods_l + 4 * 1024, mods_l + 3 * 1024, HBUF);
        GRID_BAR();
        const size_t o_w1 = kind == 0 ? WO_GM_W1 : kind == 1 ? WO_NA_W1 : WO_ML_W1, o_w2 = kind == 0 ? WO_GM_W2 : kind == 1 ? WO_NA_W2 : WO_ML_W2;
        { bf16* HID = (bf16*)(ws + WS_HID);
          { pg8::Gemm g{HBUF, WR + o_w1, M, FF, D}; pg8::StaticOrder S; S.init(M, FF, F.G, (int)blockIdx.x);
            pg8::EpiBf16<2> E{HID, FF, nullptr, 0, 0, 1.f};
            pg8::gemm_phase<pg8::EpiBf16<2>, pg8::StaticOrder, true, true>(ring, g, S, E); }
          GRID_BAR();
          { pg8::Gemm g{HID, WR + o_w2, M, D, FF}; pg8::StaticOrder S; S.init(M, D, F.G, (int)blockIdx.x);
            pg8::EpiF32 E{Y, D, nullptr};
            pg8::gemm_phase<pg8::EpiF32, pg8::StaticOrder, true, true>(ring, g, S, E); }
          GRID_BAR(); }
        if (layer < DEPTH - 1) {
            const float* mods_n = MODS + (size_t)(layer + 1) * 9 * 6144;
            const int Mn = (layer + 1 == DEPTH - 1) ? TLAT : TT;
            row_phase<true, true>(F, Mn, F.out, XC, F.out, XC, Y, norm_g + ((size_t)layer * 4 + 3) * D, mods_l + 5 * 1024,
                                  norm_g + ((size_t)(layer + 1) * 4 + 0) * D, mods_n + 1 * 1024, mods_n + 0 * 1024, HBUF);
            if (layer + 2 < DEPTH) convert_layer(F, layer + 2, WR);
            GRID_BAR();
        } else {
            row_phase<true, false>(F, TLAT, F.out, XC, F.out, XC, Y, norm_g + ((size_t)layer * 4 + 3) * D, mods_l + 5 * 1024, nullptr, nullptr, nullptr, nullptr);
        }
    }
}

extern "C" void kernel_launch(void* const* d_in, const int* in_sizes, int n_in, void* d_out, int out_size, void* d_ws, size_t ws_size, hipStream_t stream) {
    static int grid = 0;
    if (grid == 0) {
        if (n_in != 25 || out_size != TLAT * D || ws_size < WS_NEED) { fprintf(stderr, "kernel_launch: unexpected shapes: n_in %d out %d ws %zu (need %zu)\n", n_in, out_size, ws_size, (size_t)WS_NEED); grid = -1; return; }
        int dev = 0, cus = 0, per_cu = 0;
        if (hipGetDevice(&dev) != hipSuccess || hipDeviceGetAttribute(&cus, hipDeviceAttributeMultiprocessorCount, dev) != hipSuccess) { grid = -1; return; }
        if (hipFuncSetAttribute((const void*)fwd_kernel, hipFuncAttributeMaxDynamicSharedMemorySize, LDS_BYTES) != hipSuccess) { fprintf(stderr, "kernel_launch: hipFuncSetAttribute failed\n"); grid = -1; return; }
        if (hipOccupancyMaxActiveBlocksPerMultiprocessor(&per_cu, (const void*)fwd_kernel, NTHREADS, LDS_BYTES) != hipSuccess || per_cu < 1)
            fprintf(stderr, "kernel_launch: occupancy query reports %d workgroups per CU\n", per_cu);
        (void)hipGetLastError();
        grid = cus;
    }
    if (grid < 0) return;
    if (hipMemsetAsync((char*)d_ws + WS_CTL, 0, CTL_ZERO_BYTES, stream) != hipSuccess) return;
    Args a{};
    for (int i = 0; i < 25; ++i) a.in[i] = (const float*)d_in[i];
    a.out = (float*)d_out; a.ws = (unsigned char*)d_ws;
    hipLaunchKernelGGL(fwd_kernel, dim3(grid), dim3(NTHREADS), LDS_BYTES, stream, a);
}
```

```cpp
#include <hip/hip_runtime.h>
#include <cstdio>
#include <cstdint>
namespace pg8 {
#define PG8_LAS __attribute__((address_space(3)))
typedef unsigned short bf16_t;
typedef short bf16x8 __attribute__((ext_vector_type(8)));
typedef float f32x4 __attribute__((ext_vector_type(4)));
typedef unsigned u32x4 __attribute__((ext_vector_type(4)));
constexpr int BM = 256, BK = 64, HALF = 128, HTB = HALF * BK * 2  , STAGE_BYTES = 8 * HTB, NXCD = 8, WGM = 8;

__host__ __device__ __forceinline__ int lds_byte(int r, int c) { const int st = (r >> 4) * 2 + (c >> 5), rr = r & 15, cc = c & 31, ob = rr * 64 + cc * 2; return st * 1024 + (ob ^ (((ob >> 9) & 1) << 5)); }
__host__ __device__ __forceinline__ void stage_rc(int b, int& R, int& C) { const int st = b / 1024, sb = b % 1024, swz = sb ^ (((sb >> 9) & 1) << 5); R = (st >> 1) * 16 + swz / 64; C = (st & 1) * 32 + (swz % 64) / 2; }
__host__ __device__ __forceinline__ int perm32(int rho) { const int n = rho >> 4, i = rho & 15; return 8 * (i >> 2) + 4 * n + (i & 3); }

struct Unit { int pm, pn; };
struct Gemm { const bf16_t* A; const bf16_t* Bt; int M, N, K; };

struct StaticOrder {
    int nM, nN, nwg, G, c;
    __host__ __device__ void init(int M, int N, int G_, int c_) { nM = M / BM; nN = N / BM; nwg = nM * nN; G = G_; c = c_; }
    __host__ __device__ bool next(int i, Unit& u) const {
        const long L = (long)i * G + c; if (L >= nwg) return false;
        int wgid = (int)L; { const int q = nwg / NXCD, r = nwg % NXCD, xcd = wgid % NXCD, off = wgid / NXCD; wgid = (xcd < r ? xcd * (q + 1) : r * (q + 1) + (xcd - r) * q) + off; }
        const int nig = WGM * nN, gid = wgid / nig, fm = gid * WGM, gsz = (nM - fm) < WGM ? (nM - fm) : WGM;
        u.pm = fm + ((wgid % nig) % gsz); u.pn = (wgid % nig) / gsz; return true;
    }
    __device__ __forceinline__ void a_ready(const Unit&) const {}
    __device__ __forceinline__ void done(const Unit&) const {}
};

__device__ __forceinline__ unsigned cvt_pk_bf16(float lo, float hi) { unsigned r; asm volatile("v_cvt_pk_bf16_f32 %0, %1, %2" : "=v"(r) : "v"(lo), "v"(hi)); return r; }
__device__ __forceinline__ float gelu_tanh(float x) {
    const float z = x * (1.0f + 0.044715f * x * x);
    return x * __builtin_amdgcn_rcpf(1.0f + __builtin_amdgcn_exp2f(-2.302208198f * z));
}
template <int ACT> __device__ __forceinline__ f32x4 act4(f32x4 v) {
    if (ACT == 1) { v[0] = gelu_tanh(v[0]); v[1] = gelu_tanh(v[1]); v[2] = gelu_tanh(v[2]); v[3] = gelu_tanh(v[3]); }
    if (ACT == 2) { v[0] = fmaxf(v[0], 0.f); v[1] = fmaxf(v[1], 0.f); v[2] = fmaxf(v[2], 0.f); v[3] = fmaxf(v[3], 0.f); v = v * v; }
    return v;
}

template <int ACT> struct EpiBf16 {
    static constexpr bool PERM = true, AFTER_DRAIN = false;
    bf16_t* O; int ldc; const float* bias; int split_cols; size_t split_stride; float scale0;
    __device__ __forceinline__ void operator()(const f32x4 (&acc)[2][2][4][2], const Unit& u, int wr, int wc, int fr, int fq) const {
        const int row0 = u.pm * BM + wr * 64 + fr; int colt = u.pn * BM; bf16_t* base = O;
        float sc = 1.f; if (split_cols) { const int t = colt / split_cols; base += (size_t)t * split_stride; colt -= t * split_cols; if (t == 0) sc = scale0; }
        const int col0 = colt + wc * 32 + 8 * fq, bcol0 = u.pn * BM + wc * 32 + 8 * fq;
        f32x4 bv[2][2];
#pragma unroll
        for (int bj = 0; bj < 2; ++bj)
#pragma unroll
            for (int n = 0; n < 2; ++n) bv[bj][n] = bias ? *(const f32x4*)(bias + bcol0 + bj * HALF + 4 * n) : (f32x4){0.f, 0.f, 0.f, 0.f};
#pragma unroll
        for (int ai = 0; ai < 2; ++ai)
#pragma unroll
            for (int m = 0; m < 4; ++m) { bf16_t* rowp = base + (size_t)(row0 + ai * HALF + m * 16) * ldc + col0;
#pragma unroll
                for (int bj = 0; bj < 2; ++bj) { f32x4 v0 = act4<ACT>(acc[ai][bj][m][0] + bv[bj][0]), v1 = act4<ACT>(acc[ai][bj][m][1] + bv[bj][1]);
                    v0 = v0 * sc; v1 = v1 * sc; u32x4 w; w.x = cvt_pk_bf16(v0[0], v0[1]); w.y = cvt_pk_bf16(v0[2], v0[3]); w.z = cvt_pk_bf16(v1[0], v1[1]); w.w = cvt_pk_bf16(v1[2], v1[3]);
                    *(u32x4*)(rowp + bj * HALF) = w; } }
    }
};

struct EpiF32 {
    static constexpr bool PERM = false, AFTER_DRAIN = false;
    float* C; int ldc; const float* bias;
    __device__ __forceinline__ void operator()(const f32x4 (&acc)[2][2][4][2], const Unit& u, int wr, int wc, int fr, int fq) const {
        const int row0 = u.pm * BM + wr * 64 + fr, col0 = u.pn * BM + wc * 32 + 4 * fq;
        f32x4 bv[2][2];
#pragma unroll
        for (int bj = 0; bj < 2; ++bj)
#pragma unroll
            for (int n = 0; n < 2; ++n) bv[bj][n] = bias ? *(const f32x4*)(bias + col0 + bj * HALF + n * 16) : (f32x4){0.f, 0.f, 0.f, 0.f};
#pragma unroll
        for (int ai = 0; ai < 2; ++ai)
#pragma unroll
            for (int m = 0; m < 4; ++m) { float* rowp = C + (size_t)(row0 + ai * HALF + m * 16) * ldc + col0;
#pragma unroll
                for (int bj = 0; bj < 2; ++bj)
#pragma unroll
                    for (int n = 0; n < 2; ++n) *(f32x4*)(rowp + bj * HALF + n * 16) = acc[ai][bj][m][n] + bv[bj][n]; }
    }
};

struct EpiMl {
    static constexpr bool PERM = true, AFTER_DRAIN = false;
    bf16_t* P; float* G; const float* bgate;
    __device__ __forceinline__ void operator()(const f32x4 (&acc)[2][2][4][2], const Unit& u, int wr, int wc, int fr, int fq) const {
        const int row0 = u.pm * BM + wr * 64 + fr;
        if (u.pn < 12) {
            const float sc = (u.pn == 2 || u.pn == 3) ? 0.125f : 1.0f;
            const int col0 = u.pn * BM + wc * 32 + 8 * fq;
#pragma unroll
            for (int ai = 0; ai < 2; ++ai)
#pragma unroll
                for (int m = 0; m < 4; ++m) { bf16_t* rowp = P + (size_t)(row0 + ai * HALF + m * 16) * 3072 + col0;
#pragma unroll
                    for (int bj = 0; bj < 2; ++bj) { const f32x4 v0 = acc[ai][bj][m][0] * sc, v1 = acc[ai][bj][m][1] * sc;
                        u32x4 w; w.x = cvt_pk_bf16(v0[0], v0[1]); w.y = cvt_pk_bf16(v0[2], v0[3]); w.z = cvt_pk_bf16(v1[0], v1[1]); w.w = cvt_pk_bf16(v1[2], v1[3]);
                        *(u32x4*)(rowp + bj * HALF) = w; } }
        } else if (wc == 0) {
            const int col0 = 8 * fq;
            const f32x4 b0 = *(const f32x4*)(bgate + col0), b1 = *(const f32x4*)(bgate + col0 + 4);
#pragma unroll
            for (int ai = 0; ai < 2; ++ai)
#pragma unroll
                for (int m = 0; m < 4; ++m) { float* rowp = G + (size_t)(row0 + ai * HALF + m * 16) * 32 + col0;
                    *(f32x4*)(rowp) = acc[ai][0][m][0] + b0; *(f32x4*)(rowp + 4) = acc[ai][0][m][1] + b1; }
        }
    }
};

template <int ACT, int MODE, bool STATS> struct EpiSwap {
    static constexpr bool PERM = true, AFTER_DRAIN = false;
    bf16_t* VT; const float* bias; float* ST;
    __device__ __forceinline__ void operator()(const f32x4 (&acc)[2][2][4][2], const Unit& u, int wr, int wc, int fr, int fq) const {
        const int ch0 = u.pm * BM + wr * 64 + fr, tok0 = u.pn * BM + wc * 32 + 8 * fq;
#pragma unroll
        for (int bj = 0; bj < 2; ++bj) { const int tok = tok0 + bj * HALF;
            f32x4 s1a = {0.f, 0.f, 0.f, 0.f}, s1b = s1a, s2a = s1a, s2b = s1a;
            size_t tbase;
            if (MODE == 0) tbase = (size_t)(tok >> 7) * (3072 * 128) + (tok & 127);
            else { if (tok < 65536) { const int b_ = tok >> 13, t = tok & 8191; tbase = ((size_t)(b_ * 16) * 128 + (t >> 6)) * 4096 + (t & 63); }
                   else { const int l = tok - 65536; tbase = (size_t)67108864 + (size_t)((l >> 8) * 16) * 16384 + (l & 255); } }
#pragma unroll
            for (int ai = 0; ai < 2; ++ai)
#pragma unroll
                for (int m = 0; m < 4; ++m) { const int ch = ch0 + ai * HALF + m * 16; const float b = bias[ch];
                    const f32x4 v0 = act4<ACT>(acc[ai][bj][m][0] + b), v1 = act4<ACT>(acc[ai][bj][m][1] + b);
                    if (STATS) { s1a += v0; s2a += v0 * v0; s1b += v1; s2b += v1 * v1; }
                    u32x4 w; w.x = cvt_pk_bf16(v0[0], v0[1]); w.y = cvt_pk_bf16(v0[2], v0[3]); w.z = cvt_pk_bf16(v1[0], v1[1]); w.w = cvt_pk_bf16(v1[2], v1[3]);
                    size_t off;
                    if (MODE == 0) off = tbase + (size_t)ch * 128;
                    else { const int head = ch >> 6, d = ch & 63; off = tbase + ((tok < 65536) ? ((size_t)head * 128 * 4096 + (size_t)d * 64) : ((size_t)head * 16384 + (size_t)d * 256)); }
                    *(u32x4*)(VT + off) = w; }
            if (STATS) {
#pragma unroll
                for (int e = 0; e < 4; ++e) { float a0 = s1a[e], q0 = s2a[e], a1 = s1b[e], q1 = s2b[e];
#pragma unroll
                    for (int o = 1; o < 16; o <<= 1) { a0 += __shfl_xor(a0, o); q0 += __shfl_xor(q0, o); a1 += __shfl_xor(a1, o); q1 += __shfl_xor(q1, o); }
                    if (fr == 0) { typedef float f32x2v __attribute__((ext_vector_type(2)));
                        *(f32x2v*)(ST + ((size_t)(tok + e) * 24 + u.pm * 2 + wr) * 2) = (f32x2v){a0, q0};
                        *(f32x2v*)(ST + ((size_t)(tok + 4 + e) * 24 + u.pm * 2 + wr) * 2) = (f32x2v){a1, q1}; } }
            }
        }
    }
};
template <class Epi, class Sched, bool ALIGN_EPI = false, bool SP2 = false>
__device__ __forceinline__ void gemm_phase(PG8_LAS unsigned char* lds, const Gemm g, const Sched& S, const Epi& E) {
    int tid_ = threadIdx.x; asm volatile("" : "+v"(tid_));
    const int tid = tid_, wid = __builtin_amdgcn_readfirstlane(tid >> 6), lane = tid & 63, wr = wid >> 2, wc = wid & 3, fr = lane & 15, fq = lane >> 4;
    const int K = g.K, nt = K / BK;
    unsigned voffA[2], voffB[2];
#pragma unroll
    for (int i = 0; i < 2; ++i) { int R, C; stage_rc(tid * 16 + i * 8192, R, C); const int Rb = Epi::PERM ? ((R & ~31) + perm32(R & 31)) : R;
        voffA[i] = (unsigned)(R * K + C) * 2u; voffB[i] = (unsigned)(Rb * K + C) * 2u; }
    const size_t kstep = (size_t)(BK * 2);
    const size_t hstep = (size_t)HALF * K * 2;
    const size_t tstep = 2 * hstep;
    const unsigned ldsw = (unsigned)wid * 1024u;
    const int aoff = lds_byte(wr * 64 + fr, fq * 8), boff = lds_byte(wc * 32 + fr, fq * 8);
#define PG8_SA(b, h) (((b) * 2 + (h)) * HTB)
#define PG8_SB(b, h) ((4 + (b) * 2 + (h)) * HTB)
#define PG8_STAGE(bufoff, gbase, voff) do { _Pragma("unroll") for (int _i = 0; _i < 2; ++_i) \
        __builtin_amdgcn_global_load_lds((const unsigned*)((const char*)(gbase) + (voff)[_i]), (PG8_LAS unsigned*)(lds + (bufoff) + ldsw + _i * 8192), 16, 0, 0); } while (0)
#define PG8_LDA(dst, b, h) do { _Pragma("unroll") for (int m = 0; m < 4; ++m) _Pragma("unroll") for (int k = 0; k < 2; ++k) dst[m][k] = *(const PG8_LAS bf16x8*)(lds + PG8_SA(b, h) + aoff + m * 2048 + k * 1024); } while (0)
#define PG8_LDB(dst, b, h) do { _Pragma("unroll") for (int n = 0; n < 2; ++n) _Pragma("unroll") for (int k = 0; k < 2; ++k) dst[n][k] = *(const PG8_LAS bf16x8*)(lds + PG8_SB(b, h) + boff + n * 2048 + k * 1024); } while (0)
#define PG8_MMA(ai, bj, At, Bt) do { __builtin_amdgcn_s_setprio(1); _Pragma("unroll") for (int m = 0; m < 4; ++m) _Pragma("unroll") for (int n = 0; n < 2; ++n) _Pragma("unroll") for (int k = 0; k < 2; ++k) \
        acc[ai][bj][m][n] = __builtin_amdgcn_mfma_f32_16x16x32_bf16(Bt[n][k], At[m][k], acc[ai][bj][m][n], 0, 0, 0); __builtin_amdgcn_s_setprio(0); } while (0)
#define PG8_WAIT_V(n) asm volatile("s_waitcnt vmcnt(" #n ")" ::: "memory")
#define PG8_WAIT_L(n) asm volatile("s_waitcnt lgkmcnt(" #n ")" ::: "memory")
#define PG8_BAR __builtin_amdgcn_s_barrier()
#define PG8_SCHED __builtin_amdgcn_sched_barrier(0)
    Unit cur, nxt; int ui = 0;
    if (!S.next(0, cur)) return;
    f32x4 acc[2][2][4][2];
#pragma unroll
    for (int a = 0; a < 2; ++a)
#pragma unroll
        for (int b = 0; b < 2; ++b)
#pragma unroll
            for (int m = 0; m < 4; ++m)
#pragma unroll
                for (int n = 0; n < 2; ++n) acc[a][b][m][n] = (f32x4){0.f, 0.f, 0.f, 0.f};
    bf16x8 At[4][2], B0[2][2], B1[2][2];
    const char* cA = (const char*)g.A + (size_t)cur.pm * tstep; const char* cB = (const char*)g.Bt + (size_t)cur.pn * tstep;
    S.a_ready(cur);
    if constexpr (SP2) {
        PG8_STAGE(PG8_SB(0, 0), cB, voffB); PG8_STAGE(PG8_SB(0, 1), cB + hstep, voffB); PG8_STAGE(PG8_SA(0, 0), cA, voffA); PG8_STAGE(PG8_SA(0, 1), cA + hstep, voffA);
        if (wr == 1) PG8_BAR;
        PG8_WAIT_V(2); PG8_BAR;
        PG8_STAGE(PG8_SB(1, 0), cB + kstep, voffB); PG8_STAGE(PG8_SA(1, 0), cA + kstep, voffA); PG8_STAGE(PG8_SB(1, 1), cB + hstep + kstep, voffB);
        PG8_WAIT_V(6); PG8_BAR;
    } else {
        PG8_STAGE(PG8_SB(0, 0), cB, voffB); PG8_STAGE(PG8_SA(0, 0), cA, voffA); PG8_STAGE(PG8_SB(0, 1), cB + hstep, voffB); PG8_STAGE(PG8_SA(0, 1), cA + hstep, voffA);
        if (wr == 1) PG8_BAR;
        PG8_WAIT_V(4); PG8_BAR;
        PG8_STAGE(PG8_SB(1, 0), cB + kstep, voffB); PG8_STAGE(PG8_SA(1, 0), cA + kstep, voffA); PG8_STAGE(PG8_SB(1, 1), cB + hstep + kstep, voffB);
        PG8_WAIT_V(6); PG8_BAR;
    }
    for (;;) {
        const bool has_next = S.next(ui + 1, nxt);
        const char* nA = has_next ? (const char*)g.A + (size_t)nxt.pm * tstep : cA; const char* nB = has_next ? (const char*)g.Bt + (size_t)nxt.pn * tstep : cB;
        for (int t = 0; t < nt; t += 2) {
            const bool last = (t == nt - 2);
            const char* a1 = cA + (size_t)(t + 1) * kstep;
            const char* a2 = last ? nA : cA + (size_t)(t + 2) * kstep; const char* b2 = last ? nB : cB + (size_t)(t + 2) * kstep;
            const char* a3 = a2 + kstep; const char* b3 = b2 + kstep;
            if (last && has_next) S.a_ready(nxt);
            if constexpr (SP2) {
            PG8_LDB(B0, 0, 0); PG8_LDB(B1, 0, 1); PG8_SCHED; PG8_LDA(At, 0, 0); PG8_STAGE(PG8_SA(1, 1), a1 + hstep, voffA);
            PG8_WAIT_V(8); PG8_WAIT_L(0); PG8_BAR; PG8_MMA(0, 0, At, B0); PG8_MMA(0, 1, At, B1); PG8_BAR; PG8_SCHED;
            PG8_LDA(At, 0, 1); PG8_STAGE(PG8_SB(0, 0), b2, voffB); PG8_STAGE(PG8_SB(0, 1), b2 + hstep, voffB); PG8_STAGE(PG8_SA(0, 0), a2, voffA);
            PG8_WAIT_V(8); PG8_WAIT_L(0); PG8_BAR; PG8_MMA(1, 0, At, B0); PG8_MMA(1, 1, At, B1); PG8_BAR; PG8_SCHED;
            PG8_LDB(B0, 1, 0); PG8_LDB(B1, 1, 1); PG8_SCHED; PG8_LDA(At, 1, 0); PG8_STAGE(PG8_SA(0, 1), a2 + hstep, voffA);
            PG8_WAIT_V(8); PG8_WAIT_L(0); PG8_BAR; PG8_MMA(0, 0, At, B0); PG8_MMA(0, 1, At, B1); PG8_BAR; PG8_SCHED;
            PG8_LDA(At, 1, 1); PG8_STAGE(PG8_SB(1, 0), b3, voffB); PG8_STAGE(PG8_SB(1, 1), b3 + hstep, voffB); PG8_STAGE(PG8_SA(1, 0), a3, voffA);
            PG8_WAIT_V(8); PG8_WAIT_L(0); PG8_BAR; PG8_MMA(1, 0, At, B0); PG8_MMA(1, 1, At, B1); PG8_BAR; PG8_SCHED;
            } else {
            PG8_LDB(B0, 0, 0); PG8_SCHED; PG8_LDA(At, 0, 0); PG8_STAGE(PG8_SA(1, 1), a1 + hstep, voffA);
            PG8_WAIT_L(8); PG8_BAR; PG8_WAIT_L(0); PG8_MMA(0, 0, At, B0); PG8_BAR; PG8_SCHED;
            PG8_LDB(B1, 0, 1); PG8_STAGE(PG8_SB(0, 0), b2, voffB);
            PG8_BAR; PG8_WAIT_L(0); PG8_MMA(0, 1, At, B1); PG8_BAR;
            PG8_LDA(At, 0, 1); PG8_STAGE(PG8_SA(0, 0), a2, voffA);
            PG8_BAR; PG8_WAIT_L(0); PG8_MMA(1, 0, At, B0); PG8_BAR; PG8_SCHED;
            PG8_STAGE(PG8_SB(0, 1), b2 + hstep, voffB);
            PG8_WAIT_V(6); PG8_BAR; PG8_MMA(1, 1, At, B1); PG8_BAR;
            PG8_LDB(B0, 1, 0); PG8_SCHED; PG8_LDA(At, 1, 0); PG8_STAGE(PG8_SA(0, 1), a2 + hstep, voffA);
            PG8_WAIT_L(8); PG8_BAR; PG8_WAIT_L(0); PG8_MMA(0, 0, At, B0); PG8_BAR; PG8_SCHED;
            PG8_LDB(B1, 1, 1); PG8_STAGE(PG8_SB(1, 0), b3, voffB);
            PG8_BAR; PG8_WAIT_L(0); PG8_MMA(0, 1, At, B1); PG8_BAR;
            PG8_LDA(At, 1, 1); PG8_STAGE(PG8_SA(1, 0), a3, voffA);
            PG8_BAR; PG8_WAIT_L(0); PG8_MMA(1, 0, At, B0); PG8_BAR; PG8_SCHED;
            PG8_STAGE(PG8_SB(1, 1), b3 + hstep, voffB);
            PG8_WAIT_V(6); PG8_BAR; PG8_MMA(1, 1, At, B1); PG8_BAR;
            }
        }
        if constexpr (ALIGN_EPI) { if (wr == 0) PG8_BAR; }
        if constexpr (!Epi::AFTER_DRAIN) { E(acc, cur, wr, wc, fr, fq); S.done(cur); }
        if (!has_next) break;
#pragma unroll
        for (int a = 0; a < 2; ++a)
#pragma unroll
            for (int b = 0; b < 2; ++b)
#pragma unroll
                for (int m = 0; m < 4; ++m)
#pragma unroll
                    for (int n = 0; n < 2; ++n) acc[a][b][m][n] = (f32x4){0.f, 0.f, 0.f, 0.f};
        cur = nxt; cA = nA; cB = nB; ++ui;
        if constexpr (ALIGN_EPI) { if (wr == 1) PG8_BAR; }
    }
    PG8_WAIT_V(0);
    if constexpr (!ALIGN_EPI) { if (wr == 0) PG8_BAR; }
    PG8_BAR;
    if constexpr (Epi::AFTER_DRAIN) { E.fused(acc, cur, wr, wc, fr, fq, lds, wid, lane); S.done(cur); }
#undef PG8_SA
#undef PG8_SB
#undef PG8_STAGE
#undef PG8_LDA
#undef PG8_LDB
#undef PG8_MMA
#undef PG8_WAIT_V
#undef PG8_WAIT_L
#undef PG8_BAR
#undef PG8_SCHED
}
}

constexpr int D = 1024, NBATCH = 8, SEQ = 8192, CTXL = 256, DEPTH = 4, FF = 4096, GH = 3072;
constexpr int TLAT = NBATCH * SEQ, TCTX = NBATCH * CTXL, TT = TLAT + TCTX;
constexpr float NORM_EPS = 1e-6f;
constexpr int NWAVES = 8, NTHREADS = 512;

constexpr size_t MiB = 1u << 20;
constexpr size_t WS_CTL = 0, CTL_ZERO_BYTES = 64 * 1024;
constexpr size_t WS_MODS = 1 * MiB;
constexpr size_t WS_ROPE = 2 * MiB;
constexpr size_t WS_XC = 3 * MiB;
constexpr size_t WS_WA = 11 * MiB, WS_WB = 45 * MiB;
constexpr size_t WS_STATS = 79 * MiB;
constexpr size_t WS_HBUF = 92 * MiB;
constexpr size_t WS_BIG = 224 * MiB;
constexpr size_t WS_Y = 752 * MiB;
constexpr size_t WS_NEED = 1016 * MiB;
constexpr size_t WS_GM_U = WS_BIG, WS_GM_VT = WS_BIG + 396 * MiB;
constexpr size_t WS_HID = WS_BIG;
constexpr size_t WS_NA_Q = WS_BIG, WS_NA_K = WS_BIG + 132 * MiB, WS_NA_VT = WS_BIG + 264 * MiB, WS_NA_O = WS_BIG + 396 * MiB;
constexpr size_t WS_ML_P = WS_BIG, WS_ML_G = WS_BIG + 396 * MiB, WS_ML_HD = WS_BIG + 405 * MiB;
static_assert(WS_GM_VT + 396 * MiB <= 1016 * MiB && WS_ML_HD + 264 * MiB <= 1016 * MiB && WS_HID + 528 * MiB <= WS_Y, "ws map");
constexpr size_t WO_GM_IN = 0, WO_GM_OUT = (size_t)6144 * 1024, WO_GM_W1 = WO_GM_OUT + (size_t)1024 * 3072, WO_GM_W2 = WO_GM_W1 + (size_t)4096 * 1024;
constexpr size_t WO_NA_QKV = 0, WO_NA_O = (size_t)3072 * 1024, WO_NA_W1 = WO_NA_O + (size_t)1024 * 1024, WO_NA_W2 = WO_NA_W1 + (size_t)4096 * 1024;
constexpr size_t WO_ML_IN = 0, WO_ML_OUT = (size_t)3328 * 1024, WO_ML_W1 = WO_ML_OUT + (size_t)1024 * 1024, WO_ML_W2 = WO_ML_W1 + (size_t)4096 * 1024;
static_assert((WO_GM_W2 + (size_t)4096 * 1024) * 2 <= 34 * MiB, "weight region");
constexpr int CW_BAR = 1024;

constexpr int RING_OFF = 0, RING_BYTES = 131072;
constexpr int LDS_BYTES = 147456;
constexpr int LDSCTL_OFF = LDS_BYTES - 512, MISC_OFF = LDSCTL_OFF + 320;

#define GAS __attribute__((address_space(1)))
#define LAS __attribute__((address_space(3)))
typedef unsigned short bf16;
typedef unsigned v4u __attribute__((ext_vector_type(4)));
typedef unsigned v2u __attribute__((ext_vector_type(2)));
typedef float f32x4 __attribute__((ext_vector_type(4)));
typedef float f32x2 __attribute__((ext_vector_type(2)));
typedef short bf16x8 __attribute__((ext_vector_type(8)));
#define LDS_WAIT() asm volatile("s_waitcnt lgkmcnt(0)" ::: "memory")
#define VM_WAIT() asm volatile("s_waitcnt vmcnt(0)" ::: "memory")
__device__ __forceinline__ unsigned f2bf(float f) { unsigned u = __builtin_bit_cast(unsigned, f); return (u + 0x7fffu + ((u >> 16) & 1u)) >> 16; }
__device__ __forceinline__ unsigned pk2(float lo, float hi) { return f2bf(lo) | (f2bf(hi) << 16); }
__device__ __forceinline__ float bflo(unsigned w) { return __builtin_bit_cast(float, w << 16); }
__device__ __forceinline__ float bfhi(unsigned w) { return __builtin_bit_cast(float, w & 0xffff0000u); }
__device__ __forceinline__ float fexp(float x) { return __builtin_amdgcn_exp2f(x * 1.4426950408889634f); }
#define MFMA16(a, b, c) __builtin_amdgcn_mfma_f32_16x16x32_bf16((a), (b), (c), 0, 0, 0)
#define XB_TMO      128
#define XB_XCNT(j)  (256  + 64 * (j))
#define XB_XSUB(j)  (1280 + 64 * (j))
#define XB_XGEN(j)  (2304 + 64 * (j))
#define XB_TOP      3328
#define XB_TOPGEN   3392
#define XCD_BAR_WORDS 3456
#define XB_SPIN_CAP (1u << 18)

__device__ __forceinline__ unsigned xb_ld(unsigned* p)              { return __hip_atomic_load(p, __ATOMIC_RELAXED, __HIP_MEMORY_SCOPE_AGENT); }
__device__ __forceinline__ unsigned xb_add(unsigned* p, unsigned v) { return __hip_atomic_fetch_add(p, v, __ATOMIC_RELAXED, __HIP_MEMORY_SCOPE_AGENT); }
__device__ __forceinline__ unsigned xb_xcc_id() { return (unsigned)__builtin_amdgcn_s_getreg((3 << 11) | 20) & 0xFu; }
#define XB_SPIN(cond, bar) do { unsigned _sp = 0; while (cond) { __builtin_amdgcn_s_sleep(1); \
    if ((++_sp & 255u) == 0u) { if (xb_ld(&(bar)[XB_TMO])) break; if (_sp > XB_SPIN_CAP) { atomicAdd(&(bar)[XB_TMO], 1u); break; } } } } while (0)

struct XcdBarrier {
    unsigned* bar; unsigned x;
    volatile LAS unsigned* st;
};

__device__ __forceinline__ XcdBarrier xcd_barrier_post(unsigned* bar, volatile LAS unsigned* st) {
    XcdBarrier b; b.bar = bar; b.x = xb_xcc_id(); b.st = st;
    if (threadIdx.x == 0) (void)xb_add(&bar[XB_XCNT(b.x)], 1u);
    return b;
}
__device__ __forceinline__ void xcd_barrier_complete(unsigned* bar, unsigned x, unsigned& nloc, unsigned& nx) {
    const unsigned G = gridDim.x * gridDim.y * gridDim.z;
    unsigned sum, cnt, mine, sp = 0u;
    for (;;) {
        sum = 0u; cnt = 0u; mine = 0u;
#pragma unroll
        for (unsigned j = 0; j < 16; ++j) { const unsigned c = xb_ld(&bar[XB_XCNT(j)]); sum += c; cnt += (c > 0u) ? 1u : 0u; mine = (j == x) ? c : mine; }
        if (sum == G) break;
        __builtin_amdgcn_s_sleep(1);
        if ((++sp & 255u) == 0u) { if (xb_ld(&bar[XB_TMO])) break; if (sp > XB_SPIN_CAP) { atomicAdd(&bar[XB_TMO], 1u); break; } }
    }
    nloc = mine > 0u ? mine : 1u; nx = cnt > 0u ? cnt : 1u;
}

__device__ __forceinline__ void xcd_barrier(const XcdBarrier& b) {
    asm volatile("s_waitcnt vmcnt(0)" ::: "memory");
    __syncthreads();
    if (threadIdx.x == 0) {
        unsigned* bar = b.bar;
        __builtin_amdgcn_s_waitcnt(0);
        unsigned nloc = b.st[0], nx = b.st[1];
        if (nloc == 0u) { xcd_barrier_complete(bar, b.x, nloc, nx); b.st[0] = nloc; b.st[1] = nx; }
        const unsigned old = xb_add(&bar[XB_XSUB(b.x)], 1u);
        const unsigned gen = old / nloc;
        if (old + 1u == (gen + 1u) * nloc) {
            __builtin_amdgcn_fence(__ATOMIC_RELEASE, "agent");
            asm volatile("s_waitcnt vmcnt(0)" ::: "memory");
            const unsigned og = xb_add(&bar[XB_TOP], 1u);
            const unsigned tg = og / nx;
            if (og + 1u == (tg + 1u) * nx) xb_add(&bar[XB_TOPGEN], 1u);
            else XB_SPIN(xb_ld(&bar[XB_TOPGEN]) == tg, bar);
            __builtin_amdgcn_fence(__ATOMIC_ACQUIRE, "agent");
            xb_add(&bar[XB_XGEN(b.x)], 1u);
            asm volatile("s_waitcnt vmcnt(0)" ::: "memory");
        } else {
            XB_SPIN(xb_ld(&bar[XB_XGEN(b.x)]) == gen, bar);
            __builtin_amdgcn_fence(__ATOMIC_ACQUIRE, "agent");
            asm volatile("s_waitcnt vmcnt(0)" ::: "memory");
        }
    }
    __syncthreads();
}

struct Frame {
    LAS unsigned char* lds;
    int tid, lane, wave, G, gw, NGW;
    const float* in[25];
    float* out; unsigned char* ws;
};
__device__ __forceinline__ float wave_sum(float v) {
#pragma unroll
    for (int o = 1; o < 64; o <<= 1) v += __shfl_xor(v, o);
    return v;
}
__device__ __forceinline__ void transpose_item(const float* W, int K, int N, bf16* WT, LAS float* scr, int item, int lane) {
    const int nblk = N / 32, kb = item / nblk, nb = item % nblk, k0 = 64 * kb, n0 = 32 * nb;
#pragma unroll 8
    for (int i = 0; i < 32; ++i) { const int kk = 2 * i + (lane >> 5); scr[kk * 33 + (lane & 31)] = W[(size_t)(k0 + kk) * N + n0 + (lane & 31)]; }
    LDS_WAIT(); asm volatile("" ::: "memory");
    const int c = lane & 7;
#pragma unroll
    for (int j = 0; j < 4; ++j) { const int n = (lane >> 3) + 8 * j; const LAS float* s = scr + (8 * c) * 33 + n;
        v4u o; o.x = pk2(s[0 * 33], s[1 * 33]); o.y = pk2(s[2 * 33], s[3 * 33]); o.z = pk2(s[4 * 33], s[5 * 33]); o.w = pk2(s[6 * 33], s[7 * 33]);
        *(v4u*)(WT + (size_t)(n0 + n) * K + k0 + 8 * c) = o; }
    LDS_WAIT(); asm volatile("" ::: "memory");
}
__device__ __forceinline__ void convert_layer(const Frame& F0, int layer, bf16* WR) {
    Frame F = F0; asm volatile("" : "+v"(F.tid)); F.lane = F.tid & 63;
    LAS float* scr = (LAS float*)(F.lds + RING_OFF + F.wave * 16384);
    const int kind = layer % 3, j = layer / 3;
    const float *W0, *W1; int N0, K1; size_t o1, o2, o3;
    if (kind == 0) { W0 = F.in[9] + (size_t)j * 1024 * 6144; N0 = 6144; W1 = F.in[14] + (size_t)j * 3072 * 1024; K1 = 3072; o1 = WO_GM_OUT; o2 = WO_GM_W1; o3 = WO_GM_W2; }
    else if (kind == 1) { W0 = F.in[15]; N0 = 3072; W1 = F.in[18]; K1 = 1024; o1 = WO_NA_O; o2 = WO_NA_W1; o3 = WO_NA_W2; }
    else { W0 = F.in[20]; N0 = 3072; W1 = F.in[24]; K1 = 1024; o1 = WO_ML_OUT; o2 = WO_ML_W1; o3 = WO_ML_W2; }
    const float* W2 = F.in[7] + (size_t)layer * 1024 * 4096; const float* W3 = F.in[8] + (size_t)layer * 4096 * 1024;
    const int I0 = 16 * (N0 / 32), I1 = (K1 / 64) * 32, I2 = 16 * 128, I3 = 64 * 32;
    for (int it = F.gw; it < I0 + I1 + I2 + I3; it += F.NGW) {
        int r = it;
        if (r < I0) { transpose_item(W0, 1024, N0, WR, scr, r, F.lane); continue; } r -= I0;
        if (r < I1) { transpose_item(W1, K1, 1024, WR + o1, scr, r, F.lane); continue; } r -= I1;
        if (r < I2) { transpose_item(W2, 1024, 4096, WR + o2, scr, r, F.lane); continue; } r -= I2;
        transpose_item(W3, 4096, 1024, WR + o3, scr, r, F.lane);
    }
    if (kind == 2) {
        const float* wg = F.in[21];
        bf16* ext = WR + (size_t)3072 * 1024;
        for (int i = F.gw * 64 + F.lane; i < 256 * 1024; i += F.NGW * 64) { const int rr = i >> 10, d = i & 1023;
            float v = 0.f; if (rr < 32) v = wg[((size_t)(rr >> 4) * 1024 + d) * 16 + (rr & 15)];
            ext[i] = (bf16)f2bf(v); }
    }
}
__device__ __forceinline__ void mods_phase(const Frame& F0) {
    Frame F = F0; asm volatile("" : "+v"(F.tid)); F.lane = F.tid & 63;
    LAS float* cact = (LAS float*)(F.lds);
    LAS float* red = (LAS float*)(F.lds + 9 * 4096);
    float* MODS = (float*)(F.ws + WS_MODS);
    const float* c = F.in[1]; const float* cc = F.in[3];
    for (int i = F.tid; i < 9 * 1024; i += NTHREADS) { const float v = i < 8192 ? c[i] : cc[i - 8192]; cact[i] = v / (1.0f + __expf(-v)); }
    __syncthreads();
    for (int item = blockIdx.x; item < DEPTH * 96; item += F.G) {
        const int layer = item / 96, cb = item % 96, col = cb * 64 + F.lane;
        const float* W = F.in[4] + (size_t)layer * 1024 * 6144 + col;
        float a[9];
#pragma unroll
        for (int m = 0; m < 9; ++m) a[m] = 0.f;
        const int k0 = F.wave * 128;
#pragma unroll 4
        for (int k = k0; k < k0 + 128; ++k) { const float w = W[(size_t)k * 6144];
#pragma unroll
            for (int m = 0; m < 9; ++m) a[m] += cact[m * 1024 + k] * w; }
#pragma unroll
        for (int m = 0; m < 9; ++m) red[(F.wave * 9 + m) * 64 + F.lane] = a[m];
        __syncthreads();
        for (int i = F.tid; i < 9 * 64; i += NTHREADS) { const int m = i >> 6, l = i & 63; float s = 0.f;
#pragma unroll
            for (int w = 0; w < 8; ++w) s += red[(w * 9 + m) * 64 + l];
            MODS[((size_t)layer * 9 + m) * 6144 + cb * 64 + l] = s + F.in[5][(size_t)layer * 6144 + cb * 64 + l]; }
        __syncthreads();
    }
    float* ROPE = (float*)(F.ws + WS_ROPE);
    for (int i = blockIdx.x * NTHREADS + F.tid; i < 2048; i += F.G * NTHREADS) { const int pos = i >> 4, fi = i & 15;
        const float inv = exp2f(-(float)fi * (13.287712379549449f / 16.0f)); const float ang = (float)pos * inv;
        ROPE[i] = cosf(ang); ROPE[2048 + i] = sinf(ang); }
}
template <bool HAS_Y, bool HAS_H>
__device__ __forceinline__ void row_phase(const Frame& F0, int M, const float* src_lat, const float* src_ctx, float* dst_lat, float* dst_ctx,
                                          const bf16* Y, const float* gy, const float* mod_gate  ,
                                          const float* gh, const float* mod_scale, const float* mod_shift, bf16* H) {
    Frame F = F0; asm volatile("" : "+v"(F.tid)); F.lane = F.tid & 63;
    const int per = (M + F.NGW - 1) / F.NGW, r0 = F.gw * per, r1 = min(M, r0 + per);
    if (r0 >= r1) return;
    const int cl = 4 * F.lane;
    int mb_c = -1; f32x4 va[4], vb[4], vc[4];
    f32x4 xn[4]; v2u yn[4];
    { const float* xs = r0 < TLAT ? src_lat + (size_t)r0 * D : src_ctx + (size_t)(r0 - TLAT) * D;
#pragma unroll
      for (int j = 0; j < 4; ++j) { xn[j] = *(const f32x4*)(xs + cl + 256 * j); if (HAS_Y) yn[j] = *(const v2u*)(Y + (size_t)r0 * D + cl + 256 * j); } }
    for (int r = r0; r < r1; ++r) {
        f32x4 x[4]; v2u yv[4];
#pragma unroll
        for (int j = 0; j < 4; ++j) { x[j] = xn[j]; if (HAS_Y) yv[j] = yn[j]; }
        if (r + 1 < r1) { const int rn = r + 1; const float* xs = rn < TLAT ? src_lat + (size_t)rn * D : src_ctx + (size_t)(rn - TLAT) * D;
#pragma unroll
            for (int j = 0; j < 4; ++j) { xn[j] = *(const f32x4*)(xs + cl + 256 * j); if (HAS_Y) yn[j] = *(const v2u*)(Y + (size_t)rn * D + cl + 256 * j); } }
        const int mb = r < TLAT ? (r >> 13) : 8;
        if (mb != mb_c) { mb_c = mb;
#pragma unroll
            for (int j = 0; j < 4; ++j) { const int c = cl + 256 * j;
                if (HAS_Y) va[j] = *(const f32x4*)(gy + c) * *(const f32x4*)(mod_gate + (size_t)mb * 6144 + c);
                if (HAS_H) { vb[j] = *(const f32x4*)(gh + c) * (*(const f32x4*)(mod_scale + (size_t)mb * 6144 + c) + 1.0f); vc[j] = *(const f32x4*)(mod_shift + (size_t)mb * 6144 + c); } } }
        if (HAS_Y) {
            f32x4 y[4]; float ss = 0.f;
#pragma unroll
            for (int j = 0; j < 4; ++j) { y[j] = (f32x4){bflo(yv[j].x), bfhi(yv[j].x), bflo(yv[j].y), bfhi(yv[j].y)}; ss += (y[j][0] * y[j][0] + y[j][1] * y[j][1]) + (y[j][2] * y[j][2] + y[j][3] * y[j][3]); }
            const float rs = 1.0f / sqrtf(wave_sum(ss) * (1.0f / D) + NORM_EPS);
            float* xd = r < TLAT ? dst_lat + (size_t)r * D : dst_ctx + (size_t)(r - TLAT) * D;
#pragma unroll
            for (int j = 0; j < 4; ++j) { x[j] = x[j] + va[j] * (y[j] * rs); *(f32x4*)(xd + cl + 256 * j) = x[j]; }
        }
        if (HAS_H) {
            float ss = 0.f;
#pragma unroll
            for (int j = 0; j < 4; ++j) ss += (x[j][0] * x[j][0] + x[j][1] * x[j][1]) + (x[j][2] * x[j][2] + x[j][3] * x[j][3]);
            const float rs = 1.0f / sqrtf(wave_sum(ss) * (1.0f / D) + NORM_EPS);
#pragma unroll
            for (int j = 0; j < 4; ++j) { const f32x4 h = x[j] * rs * vb[j] + vc[j]; v2u w; w.x = pk2(h[0], h[1]); w.y = pk2(h[2], h[3]); *(v2u*)(H + (size_t)r * D + cl + 256 * j) = w; }
        }
    }
}

__device__ __forceinline__ void mix_phase(const Frame& F0, bool dry, int nchunks, const bf16* VT, bf16* U, const float* ST, const float* Wsp, const float* bsp, const float* lng) {
    Frame F = F0; asm volatile("" : "+v"(F.tid)); F.lane = F.tid & 63;
    constexpr int WPS = 136, TS = 784;
    LAS bf16* Wp = (LAS bf16*)(F.lds);
    LAS unsigned char* TILE = F.lds + 128 * WPS * 2;
    LAS float* rq = (LAS float*)(TILE + 128 * TS);
    LAS float* mu = rq + 128; LAS float* mm = mu + 128; LAS float* bsv = mm + 128; LAS float* gam = bsv + 128;
    const int fr = F.lane & 15, fq = F.lane >> 4;
    for (int unit = blockIdx.x; unit < nchunks * 8; unit += F.G) {
        const int chunk = unit >> 3, g = unit & 7;
        v4u ut[12];
        bf16* ubase = U + ((size_t)chunk * 128 + (F.tid >> 3)) * GH + g * 384 + (F.tid & 7) * 8;
#pragma unroll
        for (int i2 = 0; i2 < 2; ++i2)
#pragma unroll
            for (int k = 0; k < 6; ++k) ut[i2 * 6 + k] = *(const v4u*)(ubase + (size_t)i2 * 64 * GH + k * 64);
        const int c0 = F.wave * 48;
        if (F.tid < 128) { const int tok = chunk * 128 + F.tid; float s = 0.f, q = 0.f;
#pragma unroll 8
            for (int sl = 0; sl < 24; ++sl) { const f32x2 p = *(const f32x2*)(ST + ((size_t)tok * 24 + sl) * 2); s += p[0]; q += p[1]; }
            const float mean = s * (1.0f / GH), var = fmaxf(q * (1.0f / GH) - mean * mean, 0.f);
            rq[F.tid] = 1.0f / sqrtf(var + NORM_EPS); mu[F.tid] = mean; bsv[F.tid] = bsp[g * 128 + F.tid];
        } else gam[F.tid - 128] = lng[g * 384 + F.tid - 128];
        LAS unsigned char* tbase = TILE + (F.tid >> 3) * TS + (F.tid & 7) * 16;
#pragma unroll
        for (int i2 = 0; i2 < 2; ++i2)
#pragma unroll
            for (int k = 0; k < 6; ++k) *(LAS v4u*)(tbase + i2 * 64 * TS + k * 128) = ut[i2 * 6 + k];
        __syncthreads();
        asm volatile("" ::: "memory");
        bf16x8 vf[4][3];
        { const bf16* vbase = VT + ((size_t)chunk * 3072 + g * 384 + c0 + fr) * 128 + fq * 8;
#pragma unroll
          for (int ks = 0; ks < 4; ++ks)
#pragma unroll
              for (int ct = 0; ct < 3; ++ct) vf[ks][ct] = *(const bf16x8*)(vbase + (size_t)ct * 16 * 128 + ks * 32); }
        { const int p = F.tid >> 2, qs = (F.tid & 3) * 32; const float* wrow = Wsp + ((size_t)g * 128 + p) * 128 + qs; float macc = 0.f;
#pragma unroll
          for (int i = 0; i < 4; ++i) { const f32x4 w0 = *(const f32x4*)(wrow + 8 * i), w1 = *(const f32x4*)(wrow + 8 * i + 4); unsigned pk[4];
#pragma unroll
              for (int e = 0; e < 4; ++e) { const int q0 = qs + 8 * i + 2 * e; const float a = (e < 2 ? w0[2 * e] : w1[2 * e - 4]) * rq[q0], b = (e < 2 ? w0[2 * e + 1] : w1[2 * e - 3]) * rq[q0 + 1];
                  const unsigned w = pk2(a, b); pk[e] = w; macc += bflo(w) * mu[q0] + bfhi(w) * mu[q0 + 1]; }
              *(LAS v4u*)(Wp + p * WPS + qs + 8 * i) = (v4u){pk[0], pk[1], pk[2], pk[3]}; }
          macc += __shfl_xor(macc, 1); macc += __shfl_xor(macc, 2);
          if ((F.tid & 3) == 0) mm[p] = macc; }
        __syncthreads();
#pragma unroll
        for (int ph = 0; ph < 2; ++ph) {
            f32x4 acc[3][4];
#pragma unroll
            for (int ct = 0; ct < 3; ++ct)
#pragma unroll
                for (int pt = 0; pt < 4; ++pt) acc[ct][pt] = (f32x4){0.f, 0.f, 0.f, 0.f};
#pragma unroll
            for (int ks = 0; ks < 4; ++ks) {
#pragma unroll
                for (int pt = 0; pt < 4; ++pt) { const bf16x8 wf = *(const LAS bf16x8*)(Wp + (16 * (4 * ph + pt) + fr) * WPS + ks * 32 + fq * 8);
#pragma unroll
                    for (int ct = 0; ct < 3; ++ct) acc[ct][pt] = MFMA16(vf[ks][ct], wf, acc[ct][pt]); }
            }
#pragma unroll
            for (int pt = 0; pt < 4; ++pt) { const int p = 16 * (4 * ph + pt) + fr; const float mp = mm[p], bp = bsv[p];
#pragma unroll
                for (int ct = 0; ct < 3; ++ct) { const int c = c0 + 16 * ct + 4 * fq; LAS v2u* up = (LAS v2u*)(TILE + p * TS + c * 2); const v2u uu = *up;
                    const float o0 = bflo(uu.x) * (gam[c] * (acc[ct][pt][0] - mp) + bp), o1 = bfhi(uu.x) * (gam[c + 1] * (acc[ct][pt][1] - mp) + bp);
                    const float o2 = bflo(uu.y) * (gam[c + 2] * (acc[ct][pt][2] - mp) + bp), o3 = bfhi(uu.y) * (gam[c + 3] * (acc[ct][pt][3] - mp) + bp);
                    v2u w; w.x = pk2(o0, o1); w.y = pk2(o2, o3); if (dry) w = uu; *up = w; } }
            asm volatile("" ::: "memory");
        }
        __syncthreads();
        asm volatile("" ::: "memory");
#pragma unroll
        for (int i2 = 0; i2 < 2; ++i2)
#pragma unroll
            for (int k = 0; k < 6; ++k) { const v4u v = *(const LAS v4u*)(tbase + i2 * 64 * TS + k * 128); *(v4u*)(ubase + (size_t)i2 * 64 * GH + k * 64) = v; }
        __syncthreads();
    }
}

__device__ __forceinline__ int na_f(int key) { return ((key >> 1) & 1) | ((key >> 2) & 6); }
__device__ __forceinline__ int na_rs(int r) { return min(max(r - 4, 0), 120); }
__device__ __forceinline__ void na_phase(const Frame& F0, const bf16* Q, const bf16* Kb, const bf16* VT, bf16* O, const float* rpb) {
    Frame F = F0; asm volatile("" : "+v"(F.tid)); F.lane = F.tid & 63;
    constexpr int KW = 0, CK = 73728, CV = 106496, RP = 139264;
    LAS unsigned char* L = F.lds;
    LAS float* rp = (LAS float*)(L + RP);
    const int fr = F.lane & 15, fq = F.lane >> 4;
    const bf16* VTC = VT + (size_t)67108864;
    const int skey = F.tid >> 3, sc = F.tid & 7;
    for (int sidx = blockIdx.x; sidx < 512; sidx += F.G) {
        const int s = sidx < 256 ? sidx : 767 - sidx;
        const int b = s >> 6, head = (s >> 2) & 15, sp = s & 3;
        __syncthreads();
#pragma unroll
        for (int i = 0; i < 4; ++i) { const int q = F.tid + 512 * i;
            { const int key = q >> 3, c = q & 7; const v4u v = *(const v4u*)(Kb + ((size_t)TLAT + b * CTXL + key) * D + head * 64 + c * 8);
              *(LAS v4u*)(L + CK + key * 128 + ((c ^ na_f(key)) << 4)) = v; }
            { const int d = q >> 5, c = q & 31; const v4u v = *(const v4u*)(VTC + ((size_t)(b * 16 + head) * 64 + d) * 256 + c * 8);
              *(LAS v4u*)(L + CV + d * 512 + ((c ^ (d & 15)) << 4)) = v; } }
        for (int i = F.tid; i < 465; i += NTHREADS) rp[i] = rpb[head * 465 + i];
        const int r0 = 32 * sp;
        int loaded_hi = na_rs(r0 + 1) + 7;
        for (int rr = na_rs(r0); rr <= loaded_hi; ++rr) {
            const v4u v = *(const v4u*)(Kb + ((size_t)b * SEQ + rr * 64 + skey) * D + head * 64 + sc * 8);
            *(LAS v4u*)(L + KW + (rr % 9) * 8192 + skey * 128 + ((sc ^ na_f(skey)) << 4)) = v; }
        const int nsteps = (sp < 2) ? 17 : 16;
        for (int step = 0; step < nsteps; ++step) {
            const bool lat = step < 16;
            const int rbase = r0 + 2 * step;
            __syncthreads();
            v4u pre0 = {0u, 0u, 0u, 0u}, pre1 = pre0; int next_hi = loaded_hi;
            if (step + 1 < 16) { next_hi = na_rs(rbase + 3) + 7;
                if (loaded_hi + 1 <= next_hi) pre0 = *(const v4u*)(Kb + ((size_t)b * SEQ + (loaded_hi + 1) * 64 + skey) * D + head * 64 + sc * 8);
                if (loaded_hi + 2 <= next_hi) pre1 = *(const v4u*)(Kb + ((size_t)b * SEQ + (loaded_hi + 2) * 64 + skey) * D + head * 64 + sc * 8); }
            int r = 0, j = 0, qtok;
            if (lat) { r = rbase + (F.wave >> 2); j = F.wave & 3; qtok = b * SEQ + r * 64 + 16 * j + fr; }
            else qtok = TLAT + b * CTXL + sp * 128 + F.wave * 16 + fr;
            bf16x8 qf[2];
#pragma unroll
            for (int ks = 0; ks < 2; ++ks) qf[ks] = *(const bf16x8*)(Q + (size_t)qtok * D + head * 64 + ks * 32 + fq * 8);
            f32x4 oacc[4];
#pragma unroll
            for (int dt = 0; dt < 4; ++dt) oacc[dt] = (f32x4){0.f, 0.f, 0.f, 0.f};
            float m_run = -1e30f, l_run = 0.f;
            const int kcol = 8 * (fr >> 2) + (fr & 3);
            if (lat) {
                const int rs = na_rs(r);
                const int kc0 = (j == 0) ? 0 : (j == 1) ? 8 : (j == 2) ? 24 : 32;
                f32x4 sl[16];
#pragma unroll
                for (int i = 0; i < 8; ++i) { const int slot = (rs + i) % 9;
#pragma unroll
                    for (int tb = 0; tb < 2; ++tb) { const int key = kc0 + kcol + 4 * tb; f32x4 a = {0.f, 0.f, 0.f, 0.f};
#pragma unroll
                        for (int ks = 0; ks < 2; ++ks) { const bf16x8 kf = *(const LAS bf16x8*)(L + KW + slot * 8192 + key * 128 + (((ks * 4 + fq) ^ na_f(key)) << 4)); a = MFMA16(kf, qf[ks], a); }
                        sl[i * 2 + tb] = a; } }
                const int qc = 16 * j + fr, wsq = min(max(qc - 8, 0), 48);
#pragma unroll
                for (int tb = 0; tb < 2; ++tb)
#pragma unroll
                    for (int e = 0; e < 4; ++e) { const int kc = kc0 + 8 * fq + 4 * tb + e; const bool valid = (kc >= wsq) && (kc < wsq + 16); const int dc = min(max(kc - qc, -15), 15) + 15;
#pragma unroll
                        for (int i = 0; i < 8; ++i) { const int drow = rs + i - r + 7; const float bias = rp[drow * 31 + dc]; sl[i * 2 + tb][e] = valid ? sl[i * 2 + tb][e] + bias : -1e30f; } }
                float mx = -1e30f;
#pragma unroll
                for (int t = 0; t < 16; ++t) mx = fmaxf(fmaxf(fmaxf(sl[t][0], sl[t][1]), fmaxf(sl[t][2], sl[t][3])), mx);
                mx = fmaxf(mx, __shfl_xor(mx, 16)); mx = fmaxf(mx, __shfl_xor(mx, 32));
                float sum = 0.f;
#pragma unroll
                for (int t = 0; t < 16; ++t)
#pragma unroll
                    for (int e = 0; e < 4; ++e) { const float p = fexp(sl[t][e] - mx); sl[t][e] = p; sum += p; }
                m_run = mx; l_run = sum;
                const bf16* vb0 = VT + (((size_t)(b * 16 + head) * 128 + rs) * 64 + fr) * 64 + kc0 + 8 * fq;
#pragma unroll
                for (int i = 0; i < 8; ++i) { v4u pw; pw.x = pk2(sl[2 * i][0], sl[2 * i][1]); pw.y = pk2(sl[2 * i][2], sl[2 * i][3]); pw.z = pk2(sl[2 * i + 1][0], sl[2 * i + 1][1]); pw.w = pk2(sl[2 * i + 1][2], sl[2 * i + 1][3]);
                    const bf16x8 pf = __builtin_bit_cast(bf16x8, pw);
#pragma unroll
                    for (int dt = 0; dt < 4; ++dt) { const bf16x8 vf = *(const bf16x8*)(vb0 + (size_t)i * 4096 + dt * 16 * 64); oacc[dt] = MFMA16(vf, pf, oacc[dt]); } }
            }
            {
                f32x4 sx[16];
#pragma unroll
                for (int s8 = 0; s8 < 8; ++s8)
#pragma unroll
                    for (int tb = 0; tb < 2; ++tb) { const int key = 32 * s8 + kcol + 4 * tb; f32x4 a = {0.f, 0.f, 0.f, 0.f};
#pragma unroll
                        for (int ks = 0; ks < 2; ++ks) { const bf16x8 kf = *(const LAS bf16x8*)(L + CK + key * 128 + (((ks * 4 + fq) ^ na_f(key)) << 4)); a = MFMA16(kf, qf[ks], a); }
                        sx[s8 * 2 + tb] = a; }
                float mx = -1e30f;
#pragma unroll
                for (int t = 0; t < 16; ++t) mx = fmaxf(fmaxf(fmaxf(sx[t][0], sx[t][1]), fmaxf(sx[t][2], sx[t][3])), mx);
                mx = fmaxf(mx, __shfl_xor(mx, 16)); mx = fmaxf(mx, __shfl_xor(mx, 32));
                const float mnew = fmaxf(mx, m_run), alpha = fexp(m_run - mnew);
#pragma unroll
                for (int dt = 0; dt < 4; ++dt) oacc[dt] = oacc[dt] * alpha;
                float sum = l_run * alpha;
#pragma unroll
                for (int t = 0; t < 16; ++t)
#pragma unroll
                    for (int e = 0; e < 4; ++e) { const float p = fexp(sx[t][e] - mnew); sx[t][e] = p; sum += p; }
                l_run = sum;
#pragma unroll
                for (int s8 = 0; s8 < 8; ++s8) { v4u pw; pw.x = pk2(sx[2 * s8][0], sx[2 * s8][1]); pw.y = pk2(sx[2 * s8][2], sx[2 * s8][3]); pw.z = pk2(sx[2 * s8 + 1][0], sx[2 * s8 + 1][1]); pw.w = pk2(sx[2 * s8 + 1][2], sx[2 * s8 + 1][3]);
                    const bf16x8 pf = __builtin_bit_cast(bf16x8, pw);
#pragma unroll
                    for (int dt = 0; dt < 4; ++dt) { const int d = 16 * dt + fr; const bf16x8 vf = *(const LAS bf16x8*)(L + CV + d * 512 + (((4 * s8 + fq) ^ fr) << 4)); oacc[dt] = MFMA16(vf, pf, oacc[dt]); } }
            }
            l_run += __shfl_xor(l_run, 16); l_run += __shfl_xor(l_run, 32);
            const float inv = 1.0f / l_run;
#pragma unroll
            for (int dt = 0; dt < 4; ++dt) { v2u w; w.x = pk2(oacc[dt][0] * inv, oacc[dt][1] * inv); w.y = pk2(oacc[dt][2] * inv, oacc[dt][3] * inv);
                *(v2u*)(O + (size_t)qtok * D + head * 64 + 16 * dt + 4 * fq) = w; }
            __syncthreads();
            if (loaded_hi + 1 <= next_hi) *(LAS v4u*)(L + KW + ((loaded_hi + 1) % 9) * 8192 + skey * 128 + ((sc ^ na_f(skey)) << 4)) = pre0;
            if (loaded_hi + 2 <= next_hi) *(LAS v4u*)(L + KW + ((loaded_hi + 2) % 9) * 8192 + skey * 128 + ((sc ^ na_f(skey)) << 4)) = pre1;
            loaded_hi = next_hi;
        }
    }
}

__device__ __forceinline__ size_t scan_tokbase(int s, int b, int dir) { if (s < 4) return (size_t)TLAT + b * CTXL + (dir ? 3 - s : s) * 64; return (size_t)b * SEQ + (dir ? 127 - (s - 4) : s - 4) * 64; }
__device__ __forceinline__ void scan_phase(const Frame& F0, const bf16* P, const float* Gt, bf16* HD, const float* ROPE) {
    Frame F = F0; asm volatile("" : "+v"(F.tid)); F.lane = F.tid & 63;
    constexpr int LS = 72;
    LAS bf16* Qs = (LAS bf16*)(F.lds);
    LAS bf16* Ks = Qs + 64 * LS;
    LAS bf16* VTs = Ks + 64 * LS;
    LAS bf16* KwT = VTs + 80 * LS;
    LAS bf16* As = KwT + 64 * LS;
    LAS bf16* CT0 = As + 64 * LS;
    LAS bf16* CT1 = CT0 + 80 * LS;
    LAS float* ga = (LAS float*)(CT1 + 80 * LS);
    LAS float* g_u = ga, *g_M = ga + 64, *g_in = ga + 128, *g_em = ga + 192, *g_w = ga + 256, *g_dec = ga + 320;
    const int fr = F.lane & 15, fq = F.lane >> 4;
    const int soff = F.tid >> 3, seg = F.tid & 7;
    for (int unit = blockIdx.x; unit < 256; unit += F.G) {
        const int b = unit >> 5, head = (unit >> 2) & 7, dir = (unit >> 1) & 1, vh = unit & 1;
        for (int i = F.tid; i < 80 * LS; i += NTHREADS) { CT0[i] = 0; if (i >= 64 * LS) VTs[i] = (i < 65 * LS) ? (bf16)0x3F80u : (bf16)0; }
        f32x4 st[3];
#pragma unroll
        for (int x = 0; x < 3; ++x) st[x] = (f32x4){0.f, 0.f, 0.f, 0.f};
        float m_st = 0.f;
        const int tau = dir ? 63 - soff : soff;
        v4u rq_, rk_, rv_; float rgi = 0.f, rgf = 0.f;
        { const size_t tb = scan_tokbase(0, b, dir); const bf16* pr = P + (tb + soff) * 3072;
          rq_ = *(const v4u*)(pr + head * 64 + seg * 8); rk_ = *(const v4u*)(pr + 512 + head * 64 + seg * 8); rv_ = *(const v4u*)(pr + 1024 + head * 128 + vh * 64 + seg * 8);
          if (F.wave == 0) { const size_t tk = tb + (dir ? 63 - F.lane : F.lane); rgi = Gt[tk * 32 + dir * 16 + head]; rgf = Gt[tk * 32 + dir * 16 + 8 + head]; } }
        __syncthreads();
        for (int s = 0; s < 132; ++s) {
            LAS bf16* CTc = (s & 1) ? CT1 : CT0; LAS bf16* CTn = (s & 1) ? CT0 : CT1;
            const bool latent = s >= 4; const int crow = latent ? (dir ? 127 - (s - 4) : s - 4) : 0;
            const size_t tb = scan_tokbase(s, b, dir);
            float kv[8];
            { float qv[8]; const unsigned qw[4] = {rq_.x, rq_.y, rq_.z, rq_.w}, kw[4] = {rk_.x, rk_.y, rk_.z, rk_.w};
#pragma unroll
              for (int e = 0; e < 4; ++e) { qv[2 * e] = bflo(qw[e]); qv[2 * e + 1] = bfhi(qw[e]); kv[2 * e] = bflo(kw[e]); kv[2 * e + 1] = bfhi(kw[e]); }
              if (latent) {
                  const int pos = (seg < 4) ? crow : soff; const float* ct = ROPE + pos * 16 + (seg & 1) * 8; const float sgn = (seg & 2) ? 1.0f : -1.0f;
                  const f32x4 c0 = *(const f32x4*)(ct), c1 = *(const f32x4*)(ct + 4), s0 = *(const f32x4*)(ct + 2048), s1 = *(const f32x4*)(ct + 2052);
#pragma unroll
                  for (int e = 0; e < 8; ++e) { const float cs = e < 4 ? c0[e] : c1[e - 4], sn = (e < 4 ? s0[e] : s1[e - 4]) * sgn;
                      const float qp = __shfl_xor(qv[e], 2), kp = __shfl_xor(kv[e], 2);
                      qv[e] = qv[e] * cs + qp * sn; kv[e] = kv[e] * cs + kp * sn; }
              }
              v4u qo, ko; qo.x = pk2(qv[0], qv[1]); qo.y = pk2(qv[2], qv[3]); qo.z = pk2(qv[4], qv[5]); qo.w = pk2(qv[6], qv[7]);
              ko.x = pk2(kv[0], kv[1]); ko.y = pk2(kv[2], kv[3]); ko.z = pk2(kv[4], kv[5]); ko.w = pk2(kv[6], kv[7]);
              *(LAS v4u*)(Qs + tau * LS + seg * 8) = qo; *(LAS v4u*)(Ks + tau * LS + seg * 8) = ko;
              kv[0] = bflo(ko.x); kv[1] = bfhi(ko.x); kv[2] = bflo(ko.y); kv[3] = bfhi(ko.y); kv[4] = bflo(ko.z); kv[5] = bfhi(ko.z); kv[6] = bflo(ko.w); kv[7] = bfhi(ko.w);
              const unsigned vw[4] = {rv_.x, rv_.y, rv_.z, rv_.w};
#pragma unroll
              for (int e = 0; e < 4; ++e) { VTs[(seg * 8 + 2 * e) * LS + tau] = (bf16)(vw[e] & 0xffffu); VTs[(seg * 8 + 2 * e + 1) * LS + tau] = (bf16)(vw[e] >> 16); }
            }
            if (F.wave == 0) {
                const float lf = fminf(rgf, 0.f) - log1pf(__expf(-fabsf(rgf)));
                float bb = lf;
#pragma unroll
                for (int o = 1; o < 64; o <<= 1) { const float t = __shfl_up(bb, o); if (F.lane >= o) bb += t; }
                const float u = rgi - bb; float cm = u;
#pragma unroll
                for (int o = 1; o < 64; o <<= 1) { const float t = __shfl_up(cm, o); if (F.lane >= o) cm = fmaxf(cm, t); }
                const float M = fmaxf(m_st, cm);
                const float M63 = __shfl(M, 63), bl = __shfl(bb, 63);
                g_u[F.lane] = u; g_M[F.lane] = M; g_in[F.lane] = fexp(m_st - M); g_em[F.lane] = fexp(-bb - M); g_w[F.lane] = fexp(u - M63);
                if (F.lane == 0) g_dec[0] = fexp(m_st - M63);
                m_st = bl + M63;
            }
            __syncthreads();
            { const float w = g_w[tau];
#pragma unroll
              for (int e = 0; e < 8; ++e) KwT[(seg * 8 + e) * LS + tau] = (bf16)f2bf(kv[e] * w); }
            if (s + 1 < 132) { const size_t tn = scan_tokbase(s + 1, b, dir); const bf16* pr = P + (tn + soff) * 3072;
                rq_ = *(const v4u*)(pr + head * 64 + seg * 8); rk_ = *(const v4u*)(pr + 512 + head * 64 + seg * 8); rv_ = *(const v4u*)(pr + 1024 + head * 128 + vh * 64 + seg * 8);
                if (F.wave == 0) { const size_t tk = tn + (dir ? 63 - F.lane : F.lane); rgi = Gt[tk * 32 + dir * 16 + head]; rgf = Gt[tk * 32 + dir * 16 + 8 + head]; } }
            { const int tt = F.wave >> 1;
#pragma unroll
              for (int z = 0; z < 2; ++z) { const int sg = 2 * (F.wave & 1) + z; const int tq = 16 * tt + fr, sg0 = 16 * sg + 4 * fq;
                  v2u w = {0u, 0u};
                  if (sg <= tt) { f32x4 a = {0.f, 0.f, 0.f, 0.f};
#pragma unroll
                      for (int ks = 0; ks < 2; ++ks) { const bf16x8 kf = *(const LAS bf16x8*)(Ks + (16 * sg + fr) * LS + ks * 32 + fq * 8), qf = *(const LAS bf16x8*)(Qs + (16 * tt + fr) * LS + ks * 32 + fq * 8); a = MFMA16(kf, qf, a); }
                      const float Mt = g_M[tq]; float av[4];
#pragma unroll
                      for (int e = 0; e < 4; ++e) { const int sig = sg0 + e; av[e] = (sig <= tq) ? a[e] * fexp(g_u[sig] - Mt) : 0.f; }
                      w.x = pk2(av[0], av[1]); w.y = pk2(av[2], av[3]); }
                  *(LAS v2u*)(As + tq * LS + sg0) = w; } }
            __syncthreads();
            { const int tt = F.wave & 3, eh = F.wave >> 2; const int tq = 16 * tt + fr;
              f32x4 acc[3];
#pragma unroll
              for (int x = 0; x < 3; ++x) acc[x] = (f32x4){0.f, 0.f, 0.f, 0.f};
#pragma unroll
              for (int ks = 0; ks < 2; ++ks) { const bf16x8 qf = *(const LAS bf16x8*)(Qs + tq * LS + ks * 32 + fq * 8);
#pragma unroll
                  for (int x = 0; x < 3; ++x) { const int et = (x < 2) ? 2 * eh + x : 4; const bf16x8 cf = *(const LAS bf16x8*)(CTc + (16 * et + fr) * LS + ks * 32 + fq * 8); acc[x] = MFMA16(cf, qf, acc[x]); } }
              const float it = g_in[tq];
#pragma unroll
              for (int x = 0; x < 3; ++x) acc[x] = acc[x] * it;
#pragma unroll
              for (int ks = 0; ks < 2; ++ks) { const bf16x8 af = *(const LAS bf16x8*)(As + tq * LS + ks * 32 + fq * 8);
#pragma unroll
                  for (int x = 0; x < 3; ++x) { const int et = (x < 2) ? 2 * eh + x : 4; const bf16x8 vf = *(const LAS bf16x8*)(VTs + (16 * et + fr) * LS + ks * 32 + fq * 8); acc[x] = MFMA16(vf, af, acc[x]); } }
              const float den = __shfl(acc[2][0], fr);
              const float rden = 1.0f / fmaxf(fabsf(den), g_em[tq]);
              const int off = dir ? 63 - tq : tq;
              bf16* orow = HD + ((size_t)dir * TT + tb + off) * D + head * 128 + vh * 64 + 4 * fq;
#pragma unroll
              for (int x = 0; x < 2; ++x) { v2u w; w.x = pk2(acc[x][0] * rden, acc[x][1] * rden); w.y = pk2(acc[x][2] * rden, acc[x][3] * rden); *(v2u*)(orow + 16 * (2 * eh + x)) = w; }
            }
            { const int dt = F.wave & 3, eh = F.wave >> 2; const float dec = g_dec[0];
#pragma unroll
              for (int x = 0; x < 3; ++x) { if (x == 2 && eh != 0) continue; const int et = (x < 2) ? 2 * eh + x : 4;
                  st[x] = st[x] * dec;
#pragma unroll
                  for (int ks = 0; ks < 2; ++ks) { const bf16x8 vf = *(const LAS bf16x8*)(VTs + (16 * et + fr) * LS + ks * 32 + fq * 8), kf = *(const LAS bf16x8*)(KwT + (16 * dt + fr) * LS + ks * 32 + fq * 8); st[x] = MFMA16(vf, kf, st[x]); }
#pragma unroll
                  for (int e = 0; e < 4; ++e) CTn[(16 * et + 4 * fq + e) * LS + 16 * dt + fr] = (bf16)f2bf(st[x][e]); } }
            __syncthreads();
        }
    }
}
__device__ __forceinline__ void readout_phase(const Frame& F0, const bf16* HD, const bf16* P, const float* ng, bf16* H) {
    Frame F = F0; asm volatile("" : "+v"(F.tid)); F.lane = F.tid & 63;
    for (int r = F.gw; r < TT; r += F.NGW) {
        const int c = 16 * F.lane;
        const v4u f0 = *(const v4u*)(HD + (size_t)r * D + c), f1 = *(const v4u*)(HD + (size_t)r * D + c + 8);
        const v4u b0 = *(const v4u*)(HD + ((size_t)TT + r) * D + c), b1 = *(const v4u*)(HD + ((size_t)TT + r) * D + c + 8);
        const v4u o0 = *(const v4u*)(P + (size_t)r * 3072 + 2048 + c), o1 = *(const v4u*)(P + (size_t)r * 3072 + 2048 + c + 8);
        const unsigned fw[8] = {f0.x, f0.y, f0.z, f0.w, f1.x, f1.y, f1.z, f1.w}, bw[8] = {b0.x, b0.y, b0.z, b0.w, b1.x, b1.y, b1.z, b1.w}, ow[8] = {o0.x, o0.y, o0.z, o0.w, o1.x, o1.y, o1.z, o1.w};
        float h[16]; float ss = 0.f;
#pragma unroll
        for (int e = 0; e < 8; ++e) { h[2 * e] = bflo(fw[e]) + bflo(bw[e]); h[2 * e + 1] = bfhi(fw[e]) + bfhi(bw[e]); ss += h[2 * e] * h[2 * e] + h[2 * e + 1] * h[2 * e + 1]; }
        ss += __shfl_xor(ss, 1); ss += __shfl_xor(ss, 2); ss += __shfl_xor(ss, 4);
        const float rs = 1.0f / sqrtf(ss * (1.0f / 128.0f) + NORM_EPS);
        unsigned ww[8];
#pragma unroll
        for (int e = 0; e < 8; ++e) { const float oa = bflo(ow[e]), ob = bfhi(ow[e]);
            const float va = h[2 * e] * rs * ng[c + 2 * e] / (1.0f + __expf(-oa)), vb = h[2 * e + 1] * rs * ng[c + 2 * e + 1] / (1.0f + __expf(-ob)); ww[e] = pk2(va, vb); }
        *(v4u*)(H + (size_t)r * D + c) = (v4u){ww[0], ww[1], ww[2], ww[3]}; *(v4u*)(H + (size_t)r * D + c + 8) = (v4u){ww[4], ww[5], ww[6], ww[7]};
    }
}

#ifndef DUPG
#define DUPG 1
#endif
#ifndef DUPNA
#define DUPNA 1
#endif
#ifndef DUPSCAN
#define DUPSCAN 1
#endif
#define REP_G for (int rep_ = 0; rep_ < DUPG; ++rep_)
#define REP_NA for (int rep_ = 0; rep_ < DUPNA; ++rep_)
#define REP_SCAN for (int rep_ = 0; rep_ < DUPSCAN; ++rep_)
#ifndef DUPMISC
#define DUPMISC 1
#endif
#ifndef DUPMIX
#define DUPMIX 1
#endif
#ifndef DUPBAR
#define DUPBAR 1
#endif
#define REP_MISC for (int rep_ = 0; rep_ < DUPMISC; ++rep_)

struct Args { const float* in[25]; float* out; unsigned char* ws; };
__global__ void __launch_bounds__(NTHREADS, 2) fwd_kernel(Args args) {
    extern __shared__ __attribute__((aligned(16))) unsigned char lds_raw[];
    Frame F;
    F.lds = (LAS unsigned char*)lds_raw;
    F.tid = threadIdx.x; F.lane = F.tid & 63; F.wave = __builtin_amdgcn_readfirstlane(F.tid >> 6);
    F.G = gridDim.x; F.gw = blockIdx.x * NWAVES + F.wave; F.NGW = F.G * NWAVES;
#pragma unroll
    for (int i = 0; i < 25; ++i) F.in[i] = args.in[i];
    F.out = args.out; F.ws = args.ws;
    unsigned char* ws = args.ws;
    for (int u = F.tid; u < (LDS_BYTES - LDSCTL_OFF) / 4; u += NTHREADS) ((LAS unsigned*)(F.lds + LDSCTL_OFF))[u] = 0u;
    __syncthreads();
    XcdBarrier bar = xcd_barrier_post((unsigned*)(ws + WS_CTL) + CW_BAR, (volatile LAS unsigned*)(F.lds + MISC_OFF) + 8);
#define GRID_BAR() do { for (int rb_ = 0; rb_ < DUPBAR; ++rb_) xcd_barrier(bar); } while (0)
    float* MODS = (float*)(ws + WS_MODS);
    float* XC = (float*)(ws + WS_XC);
    bf16* WA = (bf16*)(ws + WS_WA); bf16* WB = (bf16*)(ws + WS_WB);
    bf16* HBUF = (bf16*)(ws + WS_HBUF);
    bf16* Y = (bf16*)(ws + WS_Y);
    float* ST = (float*)(ws + WS_STATS);
    const float* norm_g = F.in[6];
    LAS unsigned char* ring = F.lds + RING_OFF;

    REP_MISC { mods_phase(F);
    convert_layer(F, 0, WA);
    convert_layer(F, 1, WB); }
    GRID_BAR();
    REP_MISC row_phase<false, true>(F, TT, F.in[0], F.in[2], nullptr, nullptr, nullptr, nullptr, nullptr, norm_g, MODS + 1024, MODS, HBUF);
    GRID_BAR();

    for (int layer = 0; layer < DEPTH; ++layer) {
        const int kind = layer % 3, j = layer / 3, M = (layer == DEPTH - 1) ? TLAT : TT;
        bf16* WR = (layer & 1) ? WB : WA;
        const float* mods_l = MODS + (size_t)layer * 9 * 6144;
        if (kind == 0) {
            bf16* U = (bf16*)(ws + WS_GM_U); bf16* VT = (bf16*)(ws + WS_GM_VT);
            const float* b_in = F.in[10] + (size_t)j * 6144;
            REP_G { pg8::Gemm g{HBUF, WR + WO_GM_IN, M, GH, D}; pg8::StaticOrder S; S.init(M, GH, F.G, (int)blockIdx.x);
              pg8::EpiBf16<1> E{U, GH, b_in, 0, 0, 1.f};
              pg8::gemm_phase<pg8::EpiBf16<1>, pg8::StaticOrder, true, true>(ring, g, S, E); }
            REP_G { pg8::Gemm g{WR + WO_GM_IN + (size_t)GH * D, HBUF, GH, M, D}; pg8::StaticOrder S; S.init(GH, M, F.G, (int)blockIdx.x);
              pg8::EpiSwap<1, 0, true> E{VT, b_in + GH, ST};
              pg8::gemm_phase<pg8::EpiSwap<1, 0, true>, pg8::StaticOrder, true, true>(ring, g, S, E); }
            GRID_BAR();
            for (int rep_ = DUPMIX - 1; rep_ >= 0; --rep_) mix_phase(F, rep_ != 0 && ((const unsigned*)(ws + WS_CTL))[8] == 0u, M / 128, VT, U, ST, F.in[12] + (size_t)j * 8 * 128 * 128, F.in[13] + (size_t)j * 8 * 128, F.in[11] + (size_t)j * GH);
            GRID_BAR();
            REP_G { pg8::Gemm g{U, WR + WO_GM_OUT, M, D, GH}; pg8::StaticOrder S; S.init(M, D, F.G, (int)blockIdx.x);
              pg8::EpiBf16<0> E{Y, D, nullptr, 0, 0, 1.f};
              pg8::gemm_phase<pg8::EpiBf16<0>, pg8::StaticOrder, true, true>(ring, g, S, E); }
            GRID_BAR();
        } else if (kind == 1) {
            bf16* Q = (bf16*)(ws + WS_NA_Q); bf16* Kb = (bf16*)(ws + WS_NA_K); bf16* VT = (bf16*)(ws + WS_NA_VT); bf16* O = (bf16*)(ws + WS_NA_O);
            const float* b_qkv = F.in[16];
            REP_G { pg8::Gemm g{HBUF, WR + WO_NA_QKV, M, 2048, D}; pg8::StaticOrder S; S.init(M, 2048, F.G, (int)blockIdx.x);
              pg8::EpiBf16<0> E{Q, D, b_qkv, 1024, (size_t)(WS_NA_K - WS_NA_Q) / 2, 0.125f};
              pg8::gemm_phase<pg8::EpiBf16<0>, pg8::StaticOrder, true, true>(ring, g, S, E); }
            REP_G { pg8::Gemm g{WR + WO_NA_QKV + (size_t)2048 * D, HBUF, D, M, D}; pg8::StaticOrder S; S.init(D, M, F.G, (int)blockIdx.x);
              pg8::EpiSwap<0, 1, false> E{VT, b_qkv + 2048, nullptr};
              pg8::gemm_phase<pg8::EpiSwap<0, 1, false>, pg8::StaticOrder, true, true>(ring, g, S, E); }
            GRID_BAR();
            REP_NA na_phase(F, Q, Kb, VT, O, F.in[17]);
            GRID_BAR();
            REP_G { pg8::Gemm g{O, WR + WO_NA_O, M, D, D}; pg8::StaticOrder S; S.init(M, D, F.G, (int)blockIdx.x);
              pg8::EpiBf16<0> E{Y, D, F.in[19], 0, 0, 1.f};
              pg8::gemm_phase<pg8::EpiBf16<0>, pg8::StaticOrder, true, true>(ring, g, S, E); }
            GRID_BAR();
        } else {
            bf16* P = (bf16*)(ws + WS_ML_P); float* Gt = (float*)(ws + WS_ML_G); bf16* HD = (bf16*)(ws + WS_ML_HD);
            REP_G { pg8::Gemm g{HBUF, WR + WO_ML_IN, M, 3328, D}; pg8::StaticOrder S; S.init(M, 3328, F.G, (int)blockIdx.x);
              pg8::EpiMl E{P, Gt, F.in[22]};
              pg8::gemm_phase<pg8::EpiMl, pg8::StaticOrder, true, true>(ring, g, S, E); }
            GRID_BAR();
            REP_SCAN scan_phase(F, P, Gt, HD, (const float*)(ws + WS_ROPE));
            GRID_BAR();
            REP_MISC readout_phase(F, HD, P, F.in[23], HBUF);
            GRID_BAR();
            REP_G { pg8::Gemm g{HBUF, WR + WO_ML_OUT, M, D, D}; pg8::StaticOrder S; S.init(M, D, F.G, (int)blockIdx.x);
              pg8::EpiBf16<0> E{Y, D, nullptr, 0, 0, 1.f};
              pg8::gemm_phase<pg8::EpiBf16<0>, pg8::StaticOrder, true, true>(ring, g, S, E); }
            GRID_BAR();
        }
        row_phase<true, true>(F, M, layer == 0 ? F.in[0] : F.out, layer == 0 ? F.in[2] : XC, F.out, XC, Y, norm_g + ((size_t)layer * 4 + 1) * D, mods_l + 2 * 1024,
                              norm_g + ((size_t)layer * 4 + 2) * D, mods_l + 4 * 1024, mods_l + 3 * 1024, HBUF);
        GRID_BAR();
        const size_t o_w1 = kind == 0 ? WO_GM_W1 : kind == 1 ? WO_NA_W1 : WO_ML_W1, o_w2 = kind == 0 ? WO_GM_W2 : kind == 1 ? WO_NA_W2 : WO_ML_W2;
        { bf16* HID = (bf16*)(ws + WS_HID);
          REP_G { pg8::Gemm g{HBUF, WR + o_w1, M, FF, D}; pg8::StaticOrder S; S.init(M, FF, F.G, (int)blockIdx.x);
            pg8::EpiBf16<2> E{HID, FF, nullptr, 0, 0, 1.f};
            pg8::gemm_phase<pg8::EpiBf16<2>, pg8::StaticOrder, true, true>(ring, g, S, E); }
          GRID_BAR();
          REP_G { pg8::Gemm g{HID, WR + o_w2, M, D, FF}; pg8::StaticOrder S; S.init(M, D, F.G, (int)blockIdx.x);
            pg8::EpiBf16<0> E{Y, D, nullptr, 0, 0, 1.f};
            pg8::gemm_phase<pg8::EpiBf16<0>, pg8::StaticOrder, true, true>(ring, g, S, E); }
          GRID_BAR(); }
        if (layer < DEPTH - 1) {
            const float* mods_n = MODS + (size_t)(layer + 1) * 9 * 6144;
            const int Mn = (layer + 1 == DEPTH - 1) ? TLAT : TT;
            row_phase<true, true>(F, Mn, F.out, XC, F.out, XC, Y, norm_g + ((size_t)layer * 4 + 3) * D, mods_l + 5 * 1024,
                                  norm_g + ((size_t)(layer + 1) * 4 + 0) * D, mods_n + 1 * 1024, mods_n + 0 * 1024, HBUF);
            if (layer + 2 < DEPTH) convert_layer(F, layer + 2, WR);
            GRID_BAR();
        } else {
            row_phase<true, false>(F, TLAT, F.out, XC, F.out, XC, Y, norm_g + ((size_t)layer * 4 + 3) * D, mods_l + 5 * 1024, nullptr, nullptr, nullptr, nullptr);
        }
    }
}

extern "C" void kernel_launch(void* const* d_in, const int* in_sizes, int n_in, void* d_out, int out_size, void* d_ws, size_t ws_size, hipStream_t stream) {
    static int grid = 0;
    if (grid == 0) {
        if (n_in != 25 || out_size != TLAT * D || ws_size < WS_NEED) { fprintf(stderr, "kernel_launch: unexpected shapes: n_in %d out %d ws %zu (need %zu)\n", n_in, out_size, ws_size, (size_t)WS_NEED); grid = -1; return; }
        int dev = 0, cus = 0, per_cu = 0;
        if (hipGetDevice(&dev) != hipSuccess || hipDeviceGetAttribute(&cus, hipDeviceAttributeMultiprocessorCount, dev) != hipSuccess) { grid = -1; return; }
        if (hipFuncSetAttribute((const void*)fwd_kernel, hipFuncAttributeMaxDynamicSharedMemorySize, LDS_BYTES) != hipSuccess) { fprintf(stderr, "kernel_launch: hipFuncSetAttribute failed\n"); grid = -1; return; }
        if (hipOccupancyMaxActiveBlocksPerMultiprocessor(&per_cu, (const void*)fwd_kernel, NTHREADS, LDS_BYTES) != hipSuccess || per_cu < 1)
            fprintf(stderr, "kernel_launch: occupancy query reports %d workgroups per CU\n", per_cu);
        (void)hipGetLastError();
        grid = cus;
    }
    if (grid < 0) return;
    if (hipMemsetAsync((char*)d_ws + WS_CTL, 0, CTL_ZERO_BYTES, stream) != hipSuccess) return;
    Args a{};
    for (int i = 0; i < 25; ++i) a.in[i] = (const float*)d_in[i];
    a.out = (float*)d_out; a.ws = (unsigned char*)d_ws;
    hipLaunchKernelGGL(fwd_kernel, dim3(grid), dim3(NTHREADS), LDS_BYTES, stream, a);
}
```

```cpp
#include <hip/hip_runtime.h>
#include <cstdio>
#include <cstdint>
namespace pg8 {
#define PG8_LAS __attribute__((address_space(3)))
typedef unsigned short bf16_t;
typedef short bf16x8 __attribute__((ext_vector_type(8)));
typedef float f32x4 __attribute__((ext_vector_type(4)));
typedef unsigned u32x4 __attribute__((ext_vector_type(4)));
constexpr int BM = 256, BK = 64, HALF = 128, HTB = HALF * BK * 2  , STAGE_BYTES = 8 * HTB, NXCD = 8, WGM = 8;

__host__ __device__ __forceinline__ int lds_byte(int r, int c) { const int st = (r >> 4) * 2 + (c >> 5), rr = r & 15, cc = c & 31, ob = rr * 64 + cc * 2; return st * 1024 + (ob ^ (((ob >> 9) & 1) << 5)); }
__host__ __device__ __forceinline__ void stage_rc(int b, int& R, int& C) { const int st = b / 1024, sb = b % 1024, swz = sb ^ (((sb >> 9) & 1) << 5); R = (st >> 1) * 16 + swz / 64; C = (st & 1) * 32 + (swz % 64) / 2; }
__host__ __device__ __forceinline__ int perm32(int rho) { const int n = rho >> 4, i = rho & 15; return 8 * (i >> 2) + 4 * n + (i & 3); }

struct Unit { int pm, pn, pk; };
struct Gemm { const bf16_t* A; const bf16_t* Bt; int M, N, K; int Kloop; size_t kslice_bytes; };

struct StaticOrder {
    int nM, nN, nwg, G, c;
    __host__ __device__ void init(int M, int N, int G_, int c_) { nM = M / BM; nN = N / BM; nwg = nM * nN; G = G_; c = c_; }
    __host__ __device__ bool next(int i, Unit& u) const {
        const long L = (long)i * G + c; if (L >= nwg) return false;
        int wgid = (int)L; { const int q = nwg / NXCD, r = nwg % NXCD, xcd = wgid % NXCD, off = wgid / NXCD; wgid = (xcd < r ? xcd * (q + 1) : r * (q + 1) + (xcd - r) * q) + off; }
        const int nig = WGM * nN, gid = wgid / nig, fm = gid * WGM, gsz = (nM - fm) < WGM ? (nM - fm) : WGM;
        u.pm = fm + ((wgid % nig) % gsz); u.pn = (wgid % nig) / gsz; u.pk = 0; return true;
    }
    __device__ __forceinline__ void a_ready(const Unit&) const {}
    __device__ __forceinline__ void done(const Unit&) const {}
};
struct SplitOrder {
    int KP, G, c;
    __host__ __device__ void init(int KP_, int G_, int c_) { KP = KP_; G = G_; c = c_; }
    __host__ __device__ bool next(int i, Unit& u) const { const int L = i * G + c; if (L >= 32 * KP) return false; u.pm = L & 7; u.pn = (L >> 3) & 3; u.pk = L >> 5; return true; }
    __device__ __forceinline__ void a_ready(const Unit&) const {}
    __device__ __forceinline__ void done(const Unit&) const {}
};

typedef __bf16 bf16v2_t __attribute__((ext_vector_type(2))); typedef float f32x2_t __attribute__((ext_vector_type(2)));
__device__ __forceinline__ unsigned cvt_pk_bf16(float lo, float hi) { const f32x2_t v = {lo, hi}; const bf16v2_t b = __builtin_convertvector(v, bf16v2_t); return __builtin_bit_cast(unsigned, b); }
__device__ __forceinline__ float gelu_tanh(float x) {
    const float z = x * (1.0f + 0.044715f * x * x);
    return x * __builtin_amdgcn_rcpf(1.0f + __builtin_amdgcn_exp2f(-2.302208198f * z));
}
template <int ACT> __device__ __forceinline__ f32x4 act4(f32x4 v) {
    if (ACT == 1) { v[0] = gelu_tanh(v[0]); v[1] = gelu_tanh(v[1]); v[2] = gelu_tanh(v[2]); v[3] = gelu_tanh(v[3]); }
    if (ACT == 2) { v[0] = fmaxf(v[0], 0.f); v[1] = fmaxf(v[1], 0.f); v[2] = fmaxf(v[2], 0.f); v[3] = fmaxf(v[3], 0.f); v = v * v; }
    return v;
}

template <int ACT, bool HAS_BIAS = true> struct EpiBf16 {
    static constexpr bool PERM = true, AFTER_DRAIN = false;
    bf16_t* O; int ldc; const float* bias; int split_cols; size_t split_stride; float scale0;
    __device__ __forceinline__ void operator()(const f32x4 (&acc)[2][2][4][2], const Unit& u, int wr, int wc, int fr, int fq) const {
        const int row0 = u.pm * BM + wr * 64 + fr; int colt = u.pn * BM; bf16_t* base = O;
        float sc = 1.f; if (split_cols) { const int t = colt / split_cols; base += (size_t)t * split_stride; colt -= t * split_cols; if (t == 0) sc = scale0; }
        const int col0 = colt + wc * 32 + 8 * fq, bcol0 = u.pn * BM + wc * 32 + 8 * fq;
        f32x4 bv[2][2];
#pragma unroll
        for (int bj = 0; bj < 2; ++bj)
#pragma unroll
            for (int n = 0; n < 2; ++n) bv[bj][n] = HAS_BIAS ? *(const f32x4*)(bias + bcol0 + bj * HALF + 4 * n) : (f32x4){0.f, 0.f, 0.f, 0.f};
#pragma unroll
        for (int ai = 0; ai < 2; ++ai)
#pragma unroll
            for (int m = 0; m < 4; ++m) { bf16_t* rowp = base + (size_t)(row0 + ai * HALF + m * 16) * ldc + col0;
#pragma unroll
                for (int bj = 0; bj < 2; ++bj) { f32x4 v0 = acc[ai][bj][m][0], v1 = acc[ai][bj][m][1]; if (HAS_BIAS) { v0 = v0 + bv[bj][0]; v1 = v1 + bv[bj][1]; } v0 = act4<ACT>(v0); v1 = act4<ACT>(v1);
                    if (split_cols) { v0 = v0 * sc; v1 = v1 * sc; } u32x4 w; w.x = cvt_pk_bf16(v0[0], v0[1]); w.y = cvt_pk_bf16(v0[2], v0[3]); w.z = cvt_pk_bf16(v1[0], v1[1]); w.w = cvt_pk_bf16(v1[2], v1[3]);
                    *(u32x4*)(rowp + bj * HALF) = w; } }
    }
};

struct EpiF32 {
    static constexpr bool PERM = false, AFTER_DRAIN = false;
    float* C; int ldc; const float* bias;
    __device__ __forceinline__ void operator()(const f32x4 (&acc)[2][2][4][2], const Unit& u, int wr, int wc, int fr, int fq) const {
        const int row0 = u.pm * BM + wr * 64 + fr, col0 = u.pn * BM + wc * 32 + 4 * fq;
        f32x4 bv[2][2];
#pragma unroll
        for (int bj = 0; bj < 2; ++bj)
#pragma unroll
            for (int n = 0; n < 2; ++n) bv[bj][n] = bias ? *(const f32x4*)(bias + col0 + bj * HALF + n * 16) : (f32x4){0.f, 0.f, 0.f, 0.f};
#pragma unroll
        for (int ai = 0; ai < 2; ++ai)
#pragma unroll
            for (int m = 0; m < 4; ++m) { float* rowp = C + (size_t)(row0 + ai * HALF + m * 16) * ldc + col0;
#pragma unroll
                for (int bj = 0; bj < 2; ++bj)
#pragma unroll
                    for (int n = 0; n < 2; ++n) *(f32x4*)(rowp + bj * HALF + n * 16) = acc[ai][bj][m][n] + bv[bj][n]; }
    }
};

struct EpiF32P {
    static constexpr bool PERM = false, AFTER_DRAIN = false;
    float* C;
    __device__ __forceinline__ void operator()(const f32x4 (&acc)[2][2][4][2], const Unit& u, int wr, int wc, int fr, int fq) const {
        const int row0 = u.pm * BM + wr * 64 + fr, col0 = u.pn * BM + wc * 32 + 4 * fq; float* base = C + (size_t)u.pk * (2048 * 1024);
#pragma unroll
        for (int ai = 0; ai < 2; ++ai)
#pragma unroll
            for (int m = 0; m < 4; ++m) { float* rowp = base + (size_t)(row0 + ai * HALF + m * 16) * 1024 + col0;
#pragma unroll
                for (int bj = 0; bj < 2; ++bj)
#pragma unroll
                    for (int n = 0; n < 2; ++n) *(f32x4*)(rowp + bj * HALF + n * 16) = acc[ai][bj][m][n]; }
    }
};

struct EpiMl {
    static constexpr bool PERM = true, AFTER_DRAIN = false;
    bf16_t* P; float* G; const float* bgate;
    __device__ __forceinline__ void operator()(const f32x4 (&acc)[2][2][4][2], const Unit& u, int wr, int wc, int fr, int fq) const {
        const int row0 = u.pm * BM + wr * 64 + fr;
        if (u.pn < 12) {
            const float sc = (u.pn == 2 || u.pn == 3) ? 0.125f : 1.0f;
            const int col0 = u.pn * BM + wc * 32 + 8 * fq;
#pragma unroll
            for (int ai = 0; ai < 2; ++ai)
#pragma unroll
                for (int m = 0; m < 4; ++m) { bf16_t* rowp = P + (size_t)(row0 + ai * HALF + m * 16) * 3072 + col0;
#pragma unroll
                    for (int bj = 0; bj < 2; ++bj) { const f32x4 v0 = acc[ai][bj][m][0] * sc, v1 = acc[ai][bj][m][1] * sc;
                        u32x4 w; w.x = cvt_pk_bf16(v0[0], v0[1]); w.y = cvt_pk_bf16(v0[2], v0[3]); w.z = cvt_pk_bf16(v1[0], v1[1]); w.w = cvt_pk_bf16(v1[2], v1[3]);
                        *(u32x4*)(rowp + bj * HALF) = w; } }
        } else if (wc == 0) {
            const int col0 = 8 * fq;
            const f32x4 b0 = *(const f32x4*)(bgate + col0), b1 = *(const f32x4*)(bgate + col0 + 4);
#pragma unroll
            for (int ai = 0; ai < 2; ++ai)
#pragma unroll
                for (int m = 0; m < 4; ++m) { float* rowp = G + (size_t)(row0 + ai * HALF + m * 16) * 32 + col0;
                    *(f32x4*)(rowp) = acc[ai][0][m][0] + b0; *(f32x4*)(rowp + 4) = acc[ai][0][m][1] + b1; }
        }
    }
};

template <int ACT, int MODE, bool STATS> struct EpiSwap {
    static constexpr bool PERM = true, AFTER_DRAIN = false;
    bf16_t* VT; const float* bias; float* ST;
    __device__ __forceinline__ void operator()(const f32x4 (&acc)[2][2][4][2], const Unit& u, int wr, int wc, int fr, int fq) const {
        const int ch0 = u.pm * BM + wr * 64 + fr, tok0 = u.pn * BM + wc * 32 + 8 * fq;
#pragma unroll
        for (int bj = 0; bj < 2; ++bj) { const int tok = tok0 + bj * HALF;
            f32x4 s1a = {0.f, 0.f, 0.f, 0.f}, s1b = s1a, s2a = s1a, s2b = s1a;
            size_t tbase;
            if (MODE == 0) tbase = (size_t)(tok >> 7) * (3072 * 128) + (tok & 127);
            else { if (tok < 65536) { const int b_ = tok >> 13, t = tok & 8191; tbase = ((size_t)(b_ * 16) * 128 + (t >> 6)) * 4096 + (t & 63); }
                   else { const int l = tok - 65536; tbase = (size_t)67108864 + (size_t)((l >> 8) * 16) * 16384 + (l & 255); } }
#pragma unroll
            for (int ai = 0; ai < 2; ++ai)
#pragma unroll
                for (int m = 0; m < 4; ++m) { const int ch = ch0 + ai * HALF + m * 16; const float b = bias[ch];
                    const f32x4 v0 = act4<ACT>(acc[ai][bj][m][0] + b), v1 = act4<ACT>(acc[ai][bj][m][1] + b);
                    if (STATS) { s1a += v0; s2a += v0 * v0; s1b += v1; s2b += v1 * v1; }
                    u32x4 w; w.x = cvt_pk_bf16(v0[0], v0[1]); w.y = cvt_pk_bf16(v0[2], v0[3]); w.z = cvt_pk_bf16(v1[0], v1[1]); w.w = cvt_pk_bf16(v1[2], v1[3]);
                    size_t off;
                    if (MODE == 0) off = tbase + (size_t)ch * 128;
                    else { const int head = ch >> 6, d = ch & 63; off = tbase + ((tok < 65536) ? ((size_t)head * 128 * 4096 + (size_t)d * 64) : ((size_t)head * 16384 + (size_t)d * 256)); }
                    *(u32x4*)(VT + off) = w; }
            if (STATS) {
#pragma unroll
                for (int e = 0; e < 4; ++e) { float a0 = s1a[e], q0 = s2a[e], a1 = s1b[e], q1 = s2b[e];
#pragma unroll
                    for (int o = 1; o < 16; o <<= 1) { a0 += __shfl_xor(a0, o); q0 += __shfl_xor(q0, o); a1 += __shfl_xor(a1, o); q1 += __shfl_xor(q1, o); }
                    if (fr == 0) { typedef float f32x2v __attribute__((ext_vector_type(2)));
                        *(f32x2v*)(ST + ((size_t)(tok + e) * 24 + u.pm * 2 + wr) * 2) = (f32x2v){a0, q0};
                        *(f32x2v*)(ST + ((size_t)(tok + 4 + e) * 24 + u.pm * 2 + wr) * 2) = (f32x2v){a1, q1}; } }
            }
        }
    }
};
template <class Epi, class Sched, bool ALIGN_EPI = false, bool SP2 = false>
__device__ __forceinline__ void gemm_phase(PG8_LAS unsigned char* lds, const Gemm g, const Sched& S, const Epi& E, int stag_ticks = 0) {
    if (stag_ticks > 0) { const unsigned long long t0_ = __builtin_amdgcn_s_memrealtime(); const unsigned long long dl_ = (unsigned long long)(((blockIdx.x >> 3) & 7u) * (unsigned)stag_ticks);
        while (__builtin_amdgcn_s_memrealtime() - t0_ < dl_) __builtin_amdgcn_s_sleep(8); }
    int tid_ = threadIdx.x; asm volatile("" : "+v"(tid_));
    const int tid = tid_, wid = __builtin_amdgcn_readfirstlane(tid >> 6), lane = tid & 63, wr = wid >> 2, wc = wid & 3, fr = lane & 15, fq = lane >> 4;
    const int K = g.K, nt = g.Kloop / BK;
    unsigned voffA[2], voffB[2];
#pragma unroll
    for (int i = 0; i < 2; ++i) { int R, C; stage_rc(tid * 16 + i * 8192, R, C); const int Rb = Epi::PERM ? ((R & ~31) + perm32(R & 31)) : R;
        voffA[i] = (unsigned)(R * K + C) * 2u; voffB[i] = (unsigned)(Rb * K + C) * 2u; }
    const size_t kstep = (size_t)(BK * 2);
    const size_t hstep = (size_t)HALF * K * 2;
    const size_t tstep = 2 * hstep;
    const unsigned ldsw = (unsigned)wid * 1024u;
    const int aoff = lds_byte(wr * 64 + fr, fq * 8), boff = lds_byte(wc * 32 + fr, fq * 8);
#define PG8_SA(b, h) (((b) * 2 + (h)) * HTB)
#define PG8_SB(b, h) ((4 + (b) * 2 + (h)) * HTB)
#define PG8_STAGE(bufoff, gbase, voff) do { _Pragma("unroll") for (int _i = 0; _i < 2; ++_i) \
        __builtin_amdgcn_global_load_lds((const unsigned*)((const char*)(gbase) + (voff)[_i]), (PG8_LAS unsigned*)(lds + (bufoff) + ldsw + _i * 8192), 16, 0, 0); } while (0)
#define PG8_LDA(dst, b, h) do { _Pragma("unroll") for (int m = 0; m < 4; ++m) _Pragma("unroll") for (int k = 0; k < 2; ++k) dst[m][k] = *(const PG8_LAS bf16x8*)(lds + PG8_SA(b, h) + aoff + m * 2048 + k * 1024); } while (0)
#define PG8_LDB(dst, b, h) do { _Pragma("unroll") for (int n = 0; n < 2; ++n) _Pragma("unroll") for (int k = 0; k < 2; ++k) dst[n][k] = *(const PG8_LAS bf16x8*)(lds + PG8_SB(b, h) + boff + n * 2048 + k * 1024); } while (0)
#define PG8_MMA(ai, bj, At, Bt) do { __builtin_amdgcn_s_setprio(1); _Pragma("unroll") for (int m = 0; m < 4; ++m) _Pragma("unroll") for (int n = 0; n < 2; ++n) _Pragma("unroll") for (int k = 0; k < 2; ++k) \
        acc[ai][bj][m][n] = __builtin_amdgcn_mfma_f32_16x16x32_bf16(Bt[n][k], At[m][k], acc[ai][bj][m][n], 0, 0, 0); __builtin_amdgcn_s_setprio(0); } while (0)
#define PG8_WAIT_V(n) asm volatile("s_waitcnt vmcnt(" #n ")" ::: "memory")
#define PG8_WAIT_L(n) asm volatile("s_waitcnt lgkmcnt(" #n ")" ::: "memory")
#define PG8_BAR __builtin_amdgcn_s_barrier()
#define PG8_SCHED __builtin_amdgcn_sched_barrier(0)
    Unit cur, nxt; int ui = 0;
    if (!S.next(0, cur)) return;
    f32x4 acc[2][2][4][2];
#pragma unroll
    for (int a = 0; a < 2; ++a)
#pragma unroll
        for (int b = 0; b < 2; ++b)
#pragma unroll
            for (int m = 0; m < 4; ++m)
#pragma unroll
                for (int n = 0; n < 2; ++n) acc[a][b][m][n] = (f32x4){0.f, 0.f, 0.f, 0.f};
    bf16x8 At[4][2], B0[2][2], B1[2][2];
    const char* cA = (const char*)g.A + (size_t)cur.pm * tstep + (size_t)cur.pk * g.kslice_bytes; const char* cB = (const char*)g.Bt + (size_t)cur.pn * tstep + (size_t)cur.pk * g.kslice_bytes;
    S.a_ready(cur);
    if constexpr (SP2) {
        PG8_STAGE(PG8_SB(0, 0), cB, voffB); PG8_STAGE(PG8_SB(0, 1), cB + hstep, voffB); PG8_STAGE(PG8_SA(0, 0), cA, voffA); PG8_STAGE(PG8_SA(0, 1), cA + hstep, voffA);
        if (wr == 1) PG8_BAR;
        PG8_WAIT_V(2); PG8_BAR;
        PG8_STAGE(PG8_SB(1, 0), cB + kstep, voffB); PG8_STAGE(PG8_SA(1, 0), cA + kstep, voffA); PG8_STAGE(PG8_SB(1, 1), cB + hstep + kstep, voffB);
        PG8_WAIT_V(6); PG8_BAR;
    } else {
        PG8_STAGE(PG8_SB(0, 0), cB, voffB); PG8_STAGE(PG8_SA(0, 0), cA, voffA); PG8_STAGE(PG8_SB(0, 1), cB + hstep, voffB); PG8_STAGE(PG8_SA(0, 1), cA + hstep, voffA);
        if (wr == 1) PG8_BAR;
        PG8_WAIT_V(4); PG8_BAR;
        PG8_STAGE(PG8_SB(1, 0), cB + kstep, voffB); PG8_STAGE(PG8_SA(1, 0), cA + kstep, voffA); PG8_STAGE(PG8_SB(1, 1), cB + hstep + kstep, voffB);
        PG8_WAIT_V(6); PG8_BAR;
    }
    for (;;) {
        const bool has_next = S.next(ui + 1, nxt);
        const char* nA = has_next ? (const char*)g.A + (size_t)nxt.pm * tstep + (size_t)nxt.pk * g.kslice_bytes : cA; const char* nB = has_next ? (const char*)g.Bt + (size_t)nxt.pn * tstep + (size_t)nxt.pk * g.kslice_bytes : cB;
        for (int t = 0; t < nt; t += 2) {
            const bool last = (t == nt - 2);
            const char* a1 = cA + (size_t)(t + 1) * kstep;
            const char* a2 = last ? nA : cA + (size_t)(t + 2) * kstep; const char* b2 = last ? nB : cB + (size_t)(t + 2) * kstep;
            const char* a3 = a2 + kstep; const char* b3 = b2 + kstep;
            if (last && has_next) S.a_ready(nxt);
            if constexpr (SP2) {
            PG8_LDB(B0, 0, 0); PG8_LDB(B1, 0, 1); PG8_SCHED; PG8_LDA(At, 0, 0); PG8_STAGE(PG8_SA(1, 1), a1 + hstep, voffA);
            PG8_WAIT_V(8); PG8_WAIT_L(0); PG8_BAR; PG8_MMA(0, 0, At, B0); PG8_MMA(0, 1, At, B1); PG8_BAR; PG8_SCHED;
            PG8_LDA(At, 0, 1); PG8_STAGE(PG8_SB(0, 0), b2, voffB); PG8_STAGE(PG8_SB(0, 1), b2 + hstep, voffB); PG8_STAGE(PG8_SA(0, 0), a2, voffA);
            PG8_WAIT_V(8); PG8_WAIT_L(0); PG8_BAR; PG8_MMA(1, 0, At, B0); PG8_MMA(1, 1, At, B1); PG8_BAR; PG8_SCHED;
            PG8_LDB(B0, 1, 0); PG8_LDB(B1, 1, 1); PG8_SCHED; PG8_LDA(At, 1, 0); PG8_STAGE(PG8_SA(0, 1), a2 + hstep, voffA);
            PG8_WAIT_V(8); PG8_WAIT_L(0); PG8_BAR; PG8_MMA(0, 0, At, B0); PG8_MMA(0, 1, At, B1); PG8_BAR; PG8_SCHED;
            PG8_LDA(At, 1, 1); PG8_STAGE(PG8_SB(1, 0), b3, voffB); PG8_STAGE(PG8_SB(1, 1), b3 + hstep, voffB); PG8_STAGE(PG8_SA(1, 0), a3, voffA);
            PG8_WAIT_V(8); PG8_WAIT_L(0); PG8_BAR; PG8_MMA(1, 0, At, B0); PG8_MMA(1, 1, At, B1); PG8_BAR; PG8_SCHED;
            } else {
            PG8_LDB(B0, 0, 0); PG8_SCHED; PG8_LDA(At, 0, 0); PG8_STAGE(PG8_SA(1, 1), a1 + hstep, voffA);
            PG8_WAIT_L(8); PG8_BAR; PG8_WAIT_L(0); PG8_MMA(0, 0, At, B0); PG8_BAR; PG8_SCHED;
            PG8_LDB(B1, 0, 1); PG8_STAGE(PG8_SB(0, 0), b2, voffB);
            PG8_BAR; PG8_WAIT_L(0); PG8_MMA(0, 1, At, B1); PG8_BAR;
            PG8_LDA(At, 0, 1); PG8_STAGE(PG8_SA(0, 0), a2, voffA);
            PG8_BAR; PG8_WAIT_L(0); PG8_MMA(1, 0, At, B0); PG8_BAR; PG8_SCHED;
            PG8_STAGE(PG8_SB(0, 1), b2 + hstep, voffB);
            PG8_WAIT_V(6); PG8_BAR; PG8_MMA(1, 1, At, B1); PG8_BAR;
            PG8_LDB(B0, 1, 0); PG8_SCHED; PG8_LDA(At, 1, 0); PG8_STAGE(PG8_SA(0, 1), a2 + hstep, voffA);
            PG8_WAIT_L(8); PG8_BAR; PG8_WAIT_L(0); PG8_MMA(0, 0, At, B0); PG8_BAR; PG8_SCHED;
            PG8_LDB(B1, 1, 1); PG8_STAGE(PG8_SB(1, 0), b3, voffB);
            PG8_BAR; PG8_WAIT_L(0); PG8_MMA(0, 1, At, B1); PG8_BAR;
            PG8_LDA(At, 1, 1); PG8_STAGE(PG8_SA(1, 0), a3, voffA);
            PG8_BAR; PG8_WAIT_L(0); PG8_MMA(1, 0, At, B0); PG8_BAR; PG8_SCHED;
            PG8_STAGE(PG8_SB(1, 1), b3 + hstep, voffB);
            PG8_WAIT_V(6); PG8_BAR; PG8_MMA(1, 1, At, B1); PG8_BAR;
            }
        }
        if constexpr (ALIGN_EPI) { if (wr == 0) PG8_BAR; }
        if constexpr (!Epi::AFTER_DRAIN) { E(acc, cur, wr, wc, fr, fq); S.done(cur); }
        if (!has_next) break;
#pragma unroll
        for (int a = 0; a < 2; ++a)
#pragma unroll
            for (int b = 0; b < 2; ++b)
#pragma unroll
                for (int m = 0; m < 4; ++m)
#pragma unroll
                    for (int n = 0; n < 2; ++n) acc[a][b][m][n] = (f32x4){0.f, 0.f, 0.f, 0.f};
        cur = nxt; cA = nA; cB = nB; ++ui;
        if constexpr (ALIGN_EPI) { if (wr == 1) PG8_BAR; }
    }
    PG8_WAIT_V(0);
    if constexpr (!ALIGN_EPI) { if (wr == 0) PG8_BAR; }
    PG8_BAR;
    if constexpr (Epi::AFTER_DRAIN) { E.fused(acc, cur, wr, wc, fr, fq, lds, wid, lane); S.done(cur); }
#undef PG8_SA
#undef PG8_SB
#undef PG8_STAGE
#undef PG8_LDA
#undef PG8_LDB
#undef PG8_MMA
#undef PG8_WAIT_V
#undef PG8_WAIT_L
#undef PG8_BAR
#undef PG8_SCHED
}
}

constexpr int D = 1024, NBATCH = 8, SEQ = 8192, CTXL = 256, DEPTH = 4, FF = 4096, GH = 3072;
constexpr int TLAT = NBATCH * SEQ, TCTX = NBATCH * CTXL, TT = TLAT + TCTX;
constexpr float NORM_EPS = 1e-6f;
constexpr int NWAVES = 8, NTHREADS = 512;

constexpr size_t MiB = 1u << 20;
constexpr size_t WS_CTL = 0, CTL_ZERO_BYTES = 64 * 1024;
constexpr size_t WS_MODS = 1 * MiB;
constexpr size_t WS_ROPE = 2 * MiB;
constexpr size_t WS_XC = 3 * MiB;
constexpr size_t WS_WA = 11 * MiB, WS_WB = 45 * MiB;
constexpr size_t WS_STATS = 79 * MiB;
constexpr size_t WS_HBUF = 92 * MiB;
constexpr size_t WS_BIG = 224 * MiB;
constexpr size_t WS_Y = 752 * MiB;
constexpr size_t WS_NEED = 1016 * MiB;
constexpr size_t WS_GM_U = WS_BIG, WS_GM_VT = WS_BIG + 396 * MiB;
constexpr size_t WS_HID = WS_BIG;
constexpr size_t WS_NA_Q = WS_BIG, WS_NA_K = WS_BIG + 132 * MiB, WS_NA_VT = WS_BIG + 264 * MiB, WS_NA_O = WS_BIG + 396 * MiB;
constexpr size_t WS_ML_P = WS_BIG, WS_ML_G = WS_BIG + 396 * MiB, WS_ML_HD = WS_BIG + 405 * MiB;
static_assert(WS_GM_VT + 396 * MiB <= 1016 * MiB && WS_ML_HD + 264 * MiB <= 1016 * MiB && WS_HID + 528 * MiB <= WS_Y, "ws map");
constexpr size_t WO_GM_IN = 0, WO_GM_OUT = (size_t)6144 * 1024, WO_GM_W1 = WO_GM_OUT + (size_t)1024 * 3072, WO_GM_W2 = WO_GM_W1 + (size_t)4096 * 1024;
constexpr size_t WO_NA_QKV = 0, WO_NA_O = (size_t)3072 * 1024, WO_NA_W1 = WO_NA_O + (size_t)1024 * 1024, WO_NA_W2 = WO_NA_W1 + (size_t)4096 * 1024;
constexpr size_t WO_ML_IN = 0, WO_ML_OUT = (size_t)3328 * 1024, WO_ML_W1 = WO_ML_OUT + (size_t)1024 * 1024, WO_ML_W2 = WO_ML_W1 + (size_t)4096 * 1024;
static_assert((WO_GM_W2 + (size_t)4096 * 1024) * 2 <= 34 * MiB, "weight region");
constexpr int CW_BAR = 1024;

constexpr int RING_OFF = 0, RING_BYTES = 131072;
constexpr int LDS_BYTES = 147456;
constexpr int LDSCTL_OFF = LDS_BYTES - 512, MISC_OFF = LDSCTL_OFF + 320;

#define GAS __attribute__((address_space(1)))
#define LAS __attribute__((address_space(3)))
typedef unsigned short bf16;
typedef unsigned v4u __attribute__((ext_vector_type(4)));
typedef unsigned v2u __attribute__((ext_vector_type(2)));
typedef float f32x4 __attribute__((ext_vector_type(4)));
typedef float f32x2 __attribute__((ext_vector_type(2)));
typedef short bf16x8 __attribute__((ext_vector_type(8)));
#define LDS_WAIT() asm volatile("s_waitcnt lgkmcnt(0)" ::: "memory")
#define VM_WAIT() asm volatile("s_waitcnt vmcnt(0)" ::: "memory")
__device__ __forceinline__ unsigned f2bf(float f) { unsigned u = __builtin_bit_cast(unsigned, f); return (u + 0x7fffu + ((u >> 16) & 1u)) >> 16; }
typedef __bf16 bf16v2 __attribute__((ext_vector_type(2)));
__device__ __forceinline__ unsigned pk2(float lo, float hi) { const f32x2 v = {lo, hi}; const bf16v2 b = __builtin_convertvector(v, bf16v2); return __builtin_bit_cast(unsigned, b); }
__device__ __forceinline__ float bflo(unsigned w) { return __builtin_bit_cast(float, w << 16); }
__device__ __forceinline__ float bfhi(unsigned w) { return __builtin_bit_cast(float, w & 0xffff0000u); }
__device__ __forceinline__ float fexp(float x) { return __builtin_amdgcn_exp2f(x * 1.4426950408889634f); }
#define MFMA16(a, b, c) __builtin_amdgcn_mfma_f32_16x16x32_bf16((a), (b), (c), 0, 0, 0)
#define XB_TMO      128
#define XB_XCNT(j)  (256  + 64 * (j))
#define XB_XSUB(j)  (1280 + 64 * (j))
#define XB_XGEN(j)  (2304 + 64 * (j))
#define XB_TOP      3328
#define XB_TOPGEN   3392
#define XCD_BAR_WORDS 3456
#define XB_SPIN_CAP (1u << 18)

__device__ __forceinline__ unsigned xb_ld(unsigned* p)              { return __hip_atomic_load(p, __ATOMIC_RELAXED, __HIP_MEMORY_SCOPE_AGENT); }
__device__ __forceinline__ unsigned xb_add(unsigned* p, unsigned v) { return __hip_atomic_fetch_add(p, v, __ATOMIC_RELAXED, __HIP_MEMORY_SCOPE_AGENT); }
__device__ __forceinline__ unsigned xb_xcc_id() { return (unsigned)__builtin_amdgcn_s_getreg((3 << 11) | 20) & 0xFu; }
#define XB_SPIN(cond, bar) do { unsigned _sp = 0; while (cond) { __builtin_amdgcn_s_sleep(1); \
    if ((++_sp & 255u) == 0u) { if (xb_ld(&(bar)[XB_TMO])) break; if (_sp > XB_SPIN_CAP) { atomicAdd(&(bar)[XB_TMO], 1u); break; } } } } while (0)

struct XcdBarrier {
    unsigned* bar; unsigned x;
    volatile LAS unsigned* st;
};

__device__ __forceinline__ XcdBarrier xcd_barrier_post(unsigned* bar, volatile LAS unsigned* st) {
    XcdBarrier b; b.bar = bar; b.x = xb_xcc_id(); b.st = st;
    if (threadIdx.x == 0) (void)xb_add(&bar[XB_XCNT(b.x)], 1u);
    return b;
}
__device__ __forceinline__ void xcd_barrier_complete(unsigned* bar, unsigned x, unsigned& nloc, unsigned& nx) {
    const unsigned G = gridDim.x * gridDim.y * gridDim.z;
    unsigned sum, cnt, mine, sp = 0u;
    for (;;) {
        sum = 0u; cnt = 0u; mine = 0u;
#pragma unroll
        for (unsigned j = 0; j < 16; ++j) { const unsigned c = xb_ld(&bar[XB_XCNT(j)]); sum += c; cnt += (c > 0u) ? 1u : 0u; mine = (j == x) ? c : mine; }
        if (sum == G) break;
        __builtin_amdgcn_s_sleep(1);
        if ((++sp & 255u) == 0u) { if (xb_ld(&bar[XB_TMO])) break; if (sp > XB_SPIN_CAP) { atomicAdd(&bar[XB_TMO], 1u); break; } }
    }
    nloc = mine > 0u ? mine : 1u; nx = cnt > 0u ? cnt : 1u;
}

__device__ __forceinline__ void xcd_barrier(const XcdBarrier& b) {
    asm volatile("s_waitcnt vmcnt(0)" ::: "memory");
    __syncthreads();
    if (threadIdx.x == 0) {
        unsigned* bar = b.bar;
        __builtin_amdgcn_s_waitcnt(0);
        unsigned nloc = b.st[0], nx = b.st[1];
        if (nloc == 0u) { xcd_barrier_complete(bar, b.x, nloc, nx); b.st[0] = nloc; b.st[1] = nx; }
        const unsigned old = xb_add(&bar[XB_XSUB(b.x)], 1u);
        const unsigned gen = old / nloc;
        if (old + 1u == (gen + 1u) * nloc) {
            __builtin_amdgcn_fence(__ATOMIC_RELEASE, "agent");
            asm volatile("s_waitcnt vmcnt(0)" ::: "memory");
            const unsigned og = xb_add(&bar[XB_TOP], 1u);
            const unsigned tg = og / nx;
            if (og + 1u == (tg + 1u) * nx) xb_add(&bar[XB_TOPGEN], 1u);
            else XB_SPIN(xb_ld(&bar[XB_TOPGEN]) == tg, bar);
            __builtin_amdgcn_fence(__ATOMIC_ACQUIRE, "agent");
            xb_add(&bar[XB_XGEN(b.x)], 1u);
            asm volatile("s_waitcnt vmcnt(0)" ::: "memory");
        } else {
            XB_SPIN(xb_ld(&bar[XB_XGEN(b.x)]) == gen, bar);
            __builtin_amdgcn_fence(__ATOMIC_ACQUIRE, "agent");
            asm volatile("s_waitcnt vmcnt(0)" ::: "memory");
        }
    }
    __syncthreads();
}

struct Frame {
    LAS unsigned char* lds;
    int tid, lane, wave, G, gw, NGW;
    const float* in[25];
    float* out; unsigned char* ws;
};
__device__ __forceinline__ float wave_sum(float v) {
#pragma unroll
    for (int o = 1; o < 64; o <<= 1) v += __shfl_xor(v, o);
    return v;
}
__device__ __forceinline__ void transpose_item(const float* W, int K, int N, bf16* WT, LAS float* scr, int item, int lane) {
    const int nblk = N / 32, kb = item / nblk, nb = item % nblk, k0 = 64 * kb, n0 = 32 * nb;
#pragma unroll 8
    for (int i = 0; i < 32; ++i) { const int kk = 2 * i + (lane >> 5); scr[kk * 33 + (lane & 31)] = W[(size_t)(k0 + kk) * N + n0 + (lane & 31)]; }
    LDS_WAIT(); asm volatile("" ::: "memory");
    const int c = lane & 7;
#pragma unroll
    for (int j = 0; j < 4; ++j) { const int n = (lane >> 3) + 8 * j; const LAS float* s = scr + (8 * c) * 33 + n;
        v4u o; o.x = pk2(s[0 * 33], s[1 * 33]); o.y = pk2(s[2 * 33], s[3 * 33]); o.z = pk2(s[4 * 33], s[5 * 33]); o.w = pk2(s[6 * 33], s[7 * 33]);
        *(v4u*)(WT + (size_t)(n0 + n) * K + k0 + 8 * c) = o; }
    LDS_WAIT(); asm volatile("" ::: "memory");
}
__device__ __forceinline__ void convert_layer(const Frame& F0, int layer, bf16* WR) {
    Frame F = F0; asm volatile("" : "+v"(F.tid)); F.lane = F.tid & 63;
    LAS float* scr = (LAS float*)(F.lds + RING_OFF + F.wave * 16384);
    const int kind = layer % 3, j = layer / 3;
    const float *W0, *W1; int N0, K1; size_t o1, o2, o3;
    if (kind == 0) { W0 = F.in[9] + (size_t)j * 1024 * 6144; N0 = 6144; W1 = F.in[14] + (size_t)j * 3072 * 1024; K1 = 3072; o1 = WO_GM_OUT; o2 = WO_GM_W1; o3 = WO_GM_W2; }
    else if (kind == 1) { W0 = F.in[15]; N0 = 3072; W1 = F.in[18]; K1 = 1024; o1 = WO_NA_O; o2 = WO_NA_W1; o3 = WO_NA_W2; }
    else { W0 = F.in[20]; N0 = 3072; W1 = F.in[24]; K1 = 1024; o1 = WO_ML_OUT; o2 = WO_ML_W1; o3 = WO_ML_W2; }
    const float* W2 = F.in[7] + (size_t)layer * 1024 * 4096; const float* W3 = F.in[8] + (size_t)layer * 4096 * 1024;
    const int I0 = 16 * (N0 / 32), I1 = (K1 / 64) * 32, I2 = 16 * 128, I3 = 64 * 32;
    for (int it = F.gw; it < I0 + I1 + I2 + I3; it += F.NGW) {
        int r = it;
        if (r < I0) { transpose_item(W0, 1024, N0, WR, scr, r, F.lane); continue; } r -= I0;
        if (r < I1) { transpose_item(W1, K1, 1024, WR + o1, scr, r, F.lane); continue; } r -= I1;
        if (r < I2) { transpose_item(W2, 1024, 4096, WR + o2, scr, r, F.lane); continue; } r -= I2;
        transpose_item(W3, 4096, 1024, WR + o3, scr, r, F.lane);
    }
    if (kind == 2) {
        const float* wg = F.in[21];
        bf16* ext = WR + (size_t)3072 * 1024;
        for (int i = F.gw * 64 + F.lane; i < 256 * 1024; i += F.NGW * 64) { const int rr = i >> 10, d = i & 1023;
            float v = 0.f; if (rr < 32) v = wg[((size_t)(rr >> 4) * 1024 + d) * 16 + (rr & 15)];
            ext[i] = (bf16)f2bf(v); }
    }
}
__device__ __forceinline__ void mods_phase(const Frame& F0) {
    Frame F = F0; asm volatile("" : "+v"(F.tid)); F.lane = F.tid & 63;
    LAS float* cact = (LAS float*)(F.lds);
    LAS float* red = (LAS float*)(F.lds + 9 * 4096);
    float* MODS = (float*)(F.ws + WS_MODS);
    const float* c = F.in[1]; const float* cc = F.in[3];
    for (int i = F.tid; i < 9 * 1024; i += NTHREADS) { const float v = i < 8192 ? c[i] : cc[i - 8192]; cact[i] = v / (1.0f + __expf(-v)); }
    __syncthreads();
    for (int item = blockIdx.x; item < DEPTH * 96; item += F.G) {
        const int layer = item / 96, cb = item % 96, col = cb * 64 + F.lane;
        const float* W = F.in[4] + (size_t)layer * 1024 * 6144 + col;
        float a[9];
#pragma unroll
        for (int m = 0; m < 9; ++m) a[m] = 0.f;
        const int k0 = F.wave * 128;
#pragma unroll 16
        for (int k = k0; k < k0 + 128; ++k) { const float w = W[(size_t)k * 6144];
#pragma unroll
            for (int m = 0; m < 9; ++m) a[m] += cact[m * 1024 + k] * w; }
#pragma unroll
        for (int m = 0; m < 9; ++m) red[(F.wave * 9 + m) * 64 + F.lane] = a[m];
        __syncthreads();
        for (int i = F.tid; i < 9 * 64; i += NTHREADS) { const int m = i >> 6, l = i & 63; float s = 0.f;
#pragma unroll
            for (int w = 0; w < 8; ++w) s += red[(w * 9 + m) * 64 + l];
            MODS[((size_t)layer * 9 + m) * 6144 + cb * 64 + l] = s + F.in[5][(size_t)layer * 6144 + cb * 64 + l]; }
        __syncthreads();
    }
    float* ROPE = (float*)(F.ws + WS_ROPE);
    for (int i = blockIdx.x * NTHREADS + F.tid; i < 2048; i += F.G * NTHREADS) { const int pos = i >> 4, fi = i & 15;
        const float inv = exp2f(-(float)fi * (13.287712379549449f / 16.0f)); const float ang = (float)pos * inv;
        ROPE[i] = cosf(ang); ROPE[2048 + i] = sinf(ang); }
}
template <bool HAS_Y, bool HAS_H, bool SRC16, bool DST16>
__device__ __forceinline__ void row_phase(const Frame& F0, int M, const float* src_lat, const float* src_ctx, const bf16* src16, float* dst_lat, bf16* dst16,
                                          const bf16* Y, const float* gy, const float* mod_gate  ,
                                          const float* gh, const float* mod_scale, const float* mod_shift, bf16* H, const float* PART = nullptr, int KP = 0, const float* pbias = nullptr) {
    Frame F = F0; asm volatile("" : "+v"(F.tid)); F.lane = F.tid & 63;
    const int nl = TLAT / F.NGW, nrow = nl + ((M > TLAT && F.gw < M - TLAT) ? 1 : 0);
    const int lat0 = F.gw * nl;
    const int cl = 4 * F.lane;
    int mb_c = -1; f32x4 va[4], vb[4], vc[4];
    f32x4 xn[4]; v2u xn16[4]; v2u yn[4];
    { const int r0 = lat0; const float* xs = src_lat + (size_t)r0 * D;
#pragma unroll
      for (int j = 0; j < 4; ++j) { if (SRC16) xn16[j] = *(const v2u*)(src16 + (size_t)r0 * D + cl + 256 * j); else xn[j] = *(const f32x4*)(xs + cl + 256 * j);
          if (HAS_Y) yn[j] = *(const v2u*)(Y + (size_t)r0 * D + cl + 256 * j); } }
    for (int i = 0; i < nrow; ++i) {
        const int r = i < nl ? lat0 + i : TLAT + F.gw;
        f32x4 x[4]; v2u yv[4];
#pragma unroll
        for (int j = 0; j < 4; ++j) { if (SRC16) x[j] = (f32x4){bflo(xn16[j].x), bfhi(xn16[j].x), bflo(xn16[j].y), bfhi(xn16[j].y)}; else x[j] = xn[j]; if (HAS_Y) yv[j] = yn[j]; }
        if (i + 1 < nrow) { const int rn = i + 1 < nl ? lat0 + i + 1 : TLAT + F.gw; const float* xs = rn < TLAT ? src_lat + (size_t)rn * D : src_ctx + (size_t)(rn - TLAT) * D;
#pragma unroll
            for (int j = 0; j < 4; ++j) { if (SRC16) xn16[j] = *(const v2u*)(src16 + (size_t)rn * D + cl + 256 * j); else xn[j] = *(const f32x4*)(xs + cl + 256 * j);
                if (HAS_Y) yn[j] = *(const v2u*)(Y + (size_t)rn * D + cl + 256 * j); } }
        const int mb = r < TLAT ? (r >> 13) : 8;
        if (mb != mb_c) { mb_c = mb;
#pragma unroll
            for (int j = 0; j < 4; ++j) { const int c = cl + 256 * j;
                if (HAS_Y) va[j] = *(const f32x4*)(gy + c) * *(const f32x4*)(mod_gate + (size_t)mb * 6144 + c);
                if (HAS_H) { vb[j] = *(const f32x4*)(gh + c) * (*(const f32x4*)(mod_scale + (size_t)mb * 6144 + c) + 1.0f); vc[j] = *(const f32x4*)(mod_shift + (size_t)mb * 6144 + c); } } }
        if (HAS_Y) {
            f32x4 y[4]; float ss = 0.f;
            if (r >= TLAT && KP > 0) {
#pragma unroll
                for (int j = 0; j < 4; ++j) { f32x4 pv[8];
#pragma unroll
                    for (int p = 0; p < 8; ++p) pv[p] = (p < KP) ? *(const f32x4*)(PART + ((size_t)p * TCTX + (r - TLAT)) * D + cl + 256 * j) : (f32x4){0.f, 0.f, 0.f, 0.f};
                    f32x4 a = ((pv[0] + pv[1]) + (pv[2] + pv[3])) + ((pv[4] + pv[5]) + (pv[6] + pv[7]));
                    if (pbias) a = a + *(const f32x4*)(pbias + cl + 256 * j);
                    y[j] = a; }
            } else {
#pragma unroll
                for (int j = 0; j < 4; ++j) y[j] = (f32x4){bflo(yv[j].x), bfhi(yv[j].x), bflo(yv[j].y), bfhi(yv[j].y)};
            }
#pragma unroll
            for (int j = 0; j < 4; ++j) ss += (y[j][0] * y[j][0] + y[j][1] * y[j][1]) + (y[j][2] * y[j][2] + y[j][3] * y[j][3]);
            const float rs = 1.0f / sqrtf(wave_sum(ss) * (1.0f / D) + NORM_EPS);
#pragma unroll
            for (int j = 0; j < 4; ++j) { x[j] = x[j] + va[j] * (y[j] * rs);
                if (DST16) { v2u w; w.x = pk2(x[j][0], x[j][1]); w.y = pk2(x[j][2], x[j][3]); *(v2u*)(dst16 + (size_t)r * D + cl + 256 * j) = w;
                    x[j] = (f32x4){bflo(w.x), bfhi(w.x), bflo(w.y), bfhi(w.y)}; }
                else *(f32x4*)(dst_lat + (size_t)r * D + cl + 256 * j) = x[j]; }
        }
        if (HAS_H) {
            float ss = 0.f;
#pragma unroll
            for (int j = 0; j < 4; ++j) ss += (x[j][0] * x[j][0] + x[j][1] * x[j][1]) + (x[j][2] * x[j][2] + x[j][3] * x[j][3]);
            const float rs = 1.0f / sqrtf(wave_sum(ss) * (1.0f / D) + NORM_EPS);
#pragma unroll
            for (int j = 0; j < 4; ++j) { const f32x4 h = x[j] * rs * vb[j] + vc[j]; v2u w; w.x = pk2(h[0], h[1]); w.y = pk2(h[2], h[3]); *(v2u*)(H + (size_t)r * D + cl + 256 * j) = w; }
        }
    }
}

__device__ __forceinline__ void mix_phase(const Frame& F0, bool dry, int nchunks, const bf16* VT, bf16* U, const float* ST, const float* Wsp, const float* bsp, const float* lng) {
    Frame F = F0; asm volatile("" : "+v"(F.tid)); F.lane = F.tid & 63;
    constexpr int WPS = 136, TS = 784;
    LAS bf16* Wp = (LAS bf16*)(F.lds);
    LAS unsigned char* TILE = F.lds + 128 * WPS * 2;
    LAS float* rq = (LAS float*)(TILE + 128 * TS);
    LAS float* mu = rq + 128; LAS float* mm = mu + 128; LAS float* bsv = mm + 128; LAS float* gam = bsv + 128;
    const int fr = F.lane & 15, fq = F.lane >> 4;
    v4u ut[12];
    if ((int)blockIdx.x < nchunks * 8) { const int unit = blockIdx.x; const bf16* ub = U + ((size_t)(unit >> 3) * 128 + (F.tid >> 3)) * GH + (unit & 7) * 384 + (F.tid & 7) * 8;
#pragma unroll
        for (int i2 = 0; i2 < 2; ++i2)
#pragma unroll
            for (int k = 0; k < 6; ++k) ut[i2 * 6 + k] = *(const v4u*)(ub + (size_t)i2 * 64 * GH + k * 64); }
    for (int unit = blockIdx.x; unit < nchunks * 8; unit += F.G) {
        const int chunk = unit >> 3, g = unit & 7;
        bf16* ubase = U + ((size_t)chunk * 128 + (F.tid >> 3)) * GH + g * 384 + (F.tid & 7) * 8;
        const int c0 = F.wave * 48;
        if (F.tid < 128) { const int tok = chunk * 128 + F.tid; float s = 0.f, q = 0.f;
#pragma unroll 8
            for (int sl = 0; sl < 24; ++sl) { const f32x2 p = *(const f32x2*)(ST + ((size_t)tok * 24 + sl) * 2); s += p[0]; q += p[1]; }
            const float mean = s * (1.0f / GH), var = fmaxf(q * (1.0f / GH) - mean * mean, 0.f);
            rq[F.tid] = 1.0f / sqrtf(var + NORM_EPS); mu[F.tid] = mean; bsv[F.tid] = bsp[g * 128 + F.tid];
        } else gam[F.tid - 128] = lng[g * 384 + F.tid - 128];
        LAS unsigned char* tbase = TILE + (F.tid >> 3) * TS + (F.tid & 7) * 16;
#pragma unroll
        for (int i2 = 0; i2 < 2; ++i2)
#pragma unroll
            for (int k = 0; k < 6; ++k) *(LAS v4u*)(tbase + i2 * 64 * TS + k * 128) = ut[i2 * 6 + k];
        asm volatile("" ::: "memory");
        bf16x8 vf[4][3];
        { const bf16* vbase = VT + ((size_t)chunk * 3072 + g * 384 + c0 + fr) * 128 + fq * 8;
#pragma unroll
          for (int ks = 0; ks < 4; ++ks)
#pragma unroll
              for (int ct = 0; ct < 3; ++ct) vf[ks][ct] = *(const bf16x8*)(vbase + (size_t)ct * 16 * 128 + ks * 32); }
        __syncthreads();
        asm volatile("" ::: "memory");
        { const int p = F.tid >> 2, qs = (F.tid & 3) * 32; const float* wrow = Wsp + ((size_t)g * 128 + p) * 128 + qs; float macc = 0.f;
#pragma unroll
          for (int i = 0; i < 4; ++i) { const f32x4 w0 = *(const f32x4*)(wrow + 8 * i), w1 = *(const f32x4*)(wrow + 8 * i + 4); unsigned pk[4];
#pragma unroll
              for (int e = 0; e < 4; ++e) { const int q0 = qs + 8 * i + 2 * e; const float a = (e < 2 ? w0[2 * e] : w1[2 * e - 4]) * rq[q0], b = (e < 2 ? w0[2 * e + 1] : w1[2 * e - 3]) * rq[q0 + 1];
                  const unsigned w = pk2(a, b); pk[e] = w; macc += bflo(w) * mu[q0] + bfhi(w) * mu[q0 + 1]; }
              *(LAS v4u*)(Wp + p * WPS + qs + 8 * i) = (v4u){pk[0], pk[1], pk[2], pk[3]}; }
          macc += __shfl_xor(macc, 1); macc += __shfl_xor(macc, 2);
          if ((F.tid & 3) == 0) mm[p] = macc; }
        __syncthreads();
#pragma unroll
        for (int ph = 0; ph < 2; ++ph) {
            f32x4 acc[3][4];
#pragma unroll
            for (int ct = 0; ct < 3; ++ct)
#pragma unroll
                for (int pt = 0; pt < 4; ++pt) acc[ct][pt] = (f32x4){0.f, 0.f, 0.f, 0.f};
#pragma unroll
            for (int ks = 0; ks < 4; ++ks) {
#pragma unroll
                for (int pt = 0; pt < 4; ++pt) { const bf16x8 wf = *(const LAS bf16x8*)(Wp + (16 * (4 * ph + pt) + fr) * WPS + ks * 32 + fq * 8);
#pragma unroll
                    for (int ct = 0; ct < 3; ++ct) acc[ct][pt] = MFMA16(vf[ks][ct], wf, acc[ct][pt]); }
            }
#pragma unroll
            for (int pt = 0; pt < 4; ++pt) { const int p = 16 * (4 * ph + pt) + fr; const float mp = mm[p], bp = bsv[p];
#pragma unroll
                for (int ct = 0; ct < 3; ++ct) { const int c = c0 + 16 * ct + 4 * fq; LAS v2u* up = (LAS v2u*)(TILE + p * TS + c * 2); const v2u uu = *up;
                    const float o0 = bflo(uu.x) * (gam[c] * (acc[ct][pt][0] - mp) + bp), o1 = bfhi(uu.x) * (gam[c + 1] * (acc[ct][pt][1] - mp) + bp);
                    const float o2 = bflo(uu.y) * (gam[c + 2] * (acc[ct][pt][2] - mp) + bp), o3 = bfhi(uu.y) * (gam[c + 3] * (acc[ct][pt][3] - mp) + bp);
                    v2u w; w.x = pk2(o0, o1); w.y = pk2(o2, o3); if (dry) w = uu; *up = w; } }
            asm volatile("" ::: "memory");
        }
        __syncthreads();
        asm volatile("" ::: "memory");
        if (unit + F.G < nchunks * 8) { const int un = unit + F.G; const bf16* ub = U + ((size_t)(un >> 3) * 128 + (F.tid >> 3)) * GH + (un & 7) * 384 + (F.tid & 7) * 8;
#pragma unroll
            for (int i2 = 0; i2 < 2; ++i2)
#pragma unroll
                for (int k = 0; k < 6; ++k) ut[i2 * 6 + k] = *(const v4u*)(ub + (size_t)i2 * 64 * GH + k * 64); }
#pragma unroll
        for (int i2 = 0; i2 < 2; ++i2)
#pragma unroll
            for (int k = 0; k < 6; ++k) { const v4u v = *(const LAS v4u*)(tbase + i2 * 64 * TS + k * 128); *(v4u*)(ubase + (size_t)i2 * 64 * GH + k * 64) = v; }
        __syncthreads();
    }
}

__device__ __forceinline__ int na_f(int key) { return ((key >> 1) & 1) | ((key >> 2) & 6); }
__device__ __forceinline__ int na_rs(int r) { return min(max(r - 4, 0), 120); }
__device__ __forceinline__ void na_phase(const Frame& F0, const bf16* Q, const bf16* Kb, const bf16* VT, bf16* O, const float* rpb) {
    Frame F = F0; asm volatile("" : "+v"(F.tid)); F.lane = F.tid & 63;
    constexpr int KW = 0, CK = 73728, CV = 106496, RP = 139264;
    LAS unsigned char* L = F.lds;
    LAS float* rp = (LAS float*)(L + RP);
    const int fr = F.lane & 15, fq = F.lane >> 4;
    const bf16* VTC = VT + (size_t)67108864;
    const int skey = F.tid >> 3, sc = F.tid & 7;
    for (int sidx = blockIdx.x; sidx < 512; sidx += F.G) {
        const int s = sidx < 256 ? sidx : 767 - sidx;
        const int b = s >> 6, head = (s >> 2) & 15, sp = s & 3;
        __syncthreads();
#pragma unroll
        for (int i = 0; i < 4; ++i) { const int q = F.tid + 512 * i;
            { const int key = q >> 3, c = q & 7; const v4u v = *(const v4u*)(Kb + ((size_t)TLAT + b * CTXL + key) * D + head * 64 + c * 8);
              *(LAS v4u*)(L + CK + key * 128 + ((c ^ na_f(key)) << 4)) = v; }
            { const int d = q >> 5, c = q & 31; const v4u v = *(const v4u*)(VTC + ((size_t)(b * 16 + head) * 64 + d) * 256 + c * 8);
              *(LAS v4u*)(L + CV + d * 512 + ((c ^ (d & 15)) << 4)) = v; } }
        for (int i = F.tid; i < 15 * 64; i += NTHREADS) { const int dr = i >> 6, cc = i & 63; rp[i] = cc < 31 ? rpb[head * 465 + dr * 31 + cc] * 1.4426950408889634f : -1e30f; }
        const int r0 = 32 * sp;
        int loaded_hi = na_rs(r0 + 1) + 7;
        for (int rr = na_rs(r0); rr <= loaded_hi; ++rr) {
            const v4u v = *(const v4u*)(Kb + ((size_t)b * SEQ + rr * 64 + skey) * D + head * 64 + sc * 8);
            *(LAS v4u*)(L + KW + (rr % 9) * 8192 + skey * 128 + ((sc ^ na_f(skey)) << 4)) = v; }
        const int nsteps = (sp < 2) ? 17 : 16;
        bf16x8 qn[2];
        { const int qt0 = b * SEQ + (r0 + (F.wave >> 2)) * 64 + 16 * (F.wave & 3) + fr;
#pragma unroll
          for (int ks = 0; ks < 2; ++ks) qn[ks] = *(const bf16x8*)(Q + (size_t)qt0 * D + head * 64 + ks * 32 + fq * 8); }
        for (int step = 0; step < nsteps; ++step) {
            const bool lat = step < 16;
            const int rbase = r0 + 2 * step;
            __syncthreads();
            v4u pre0 = {0u, 0u, 0u, 0u}, pre1 = pre0; int next_hi = loaded_hi;
            if (step + 1 < 16) { next_hi = na_rs(rbase + 3) + 7;
                if (loaded_hi + 1 <= next_hi) pre0 = *(const v4u*)(Kb + ((size_t)b * SEQ + (loaded_hi + 1) * 64 + skey) * D + head * 64 + sc * 8);
                if (loaded_hi + 2 <= next_hi) pre1 = *(const v4u*)(Kb + ((size_t)b * SEQ + (loaded_hi + 2) * 64 + skey) * D + head * 64 + sc * 8); }
            int r = 0, j = 0, qtok;
            if (lat) { r = rbase + (F.wave >> 2); j = F.wave & 3; qtok = b * SEQ + r * 64 + 16 * j + fr; }
            else qtok = TLAT + b * CTXL + sp * 128 + F.wave * 16 + fr;
            bf16x8 qf[2];
#pragma unroll
            for (int ks = 0; ks < 2; ++ks) qf[ks] = qn[ks];
            if (step + 1 < nsteps) { const int qt2 = (step + 1 < 16) ? (b * SEQ + (rbase + 2 + (F.wave >> 2)) * 64 + 16 * (F.wave & 3) + fr) : (TLAT + b * CTXL + sp * 128 + F.wave * 16 + fr);
#pragma unroll
                for (int ks = 0; ks < 2; ++ks) qn[ks] = *(const bf16x8*)(Q + (size_t)qt2 * D + head * 64 + ks * 32 + fq * 8); }
            f32x4 oacc[4];
#pragma unroll
            for (int dt = 0; dt < 4; ++dt) oacc[dt] = (f32x4){0.f, 0.f, 0.f, 0.f};
            float m_run = -1e30f, l_run = 0.f;
            const int kcol = 8 * (fr >> 2) + (fr & 3);
            if (lat) {
                const int rs = na_rs(r);
                const int kc0 = (j == 0) ? 0 : (j == 1) ? 8 : (j == 2) ? 24 : 32;
                f32x4 sl[16];
#pragma unroll
                for (int i = 0; i < 8; ++i) { const int slot = (rs + i) % 9;
#pragma unroll
                    for (int tb = 0; tb < 2; ++tb) { const int key = kc0 + kcol + 4 * tb; f32x4 a = {0.f, 0.f, 0.f, 0.f};
#pragma unroll
                        for (int ks = 0; ks < 2; ++ks) { const bf16x8 kf = *(const LAS bf16x8*)(L + KW + slot * 8192 + key * 128 + (((ks * 4 + fq) ^ na_f(key)) << 4)); a = MFMA16(kf, qf[ks], a); }
                        sl[i * 2 + tb] = a; } }
                const int qc = 16 * j + fr, wsq = min(max(qc - 8, 0), 48);
                const LAS float* rpw = rp + (rs - r + 7) * 64;
#pragma unroll
                for (int tb = 0; tb < 2; ++tb)
#pragma unroll
                    for (int e = 0; e < 4; ++e) { const int kc = kc0 + 8 * fq + 4 * tb + e; const bool valid = (kc >= wsq) && (kc < wsq + 16); const int cidx = valid ? (min(max(kc - qc, -15), 15) + 15) : 32;
#pragma unroll
                        for (int i = 0; i < 8; ++i) sl[i * 2 + tb][e] += rpw[i * 64 + cidx]; }
                float mx = -1e30f;
#pragma unroll
                for (int t = 0; t < 16; ++t) mx = fmaxf(fmaxf(fmaxf(sl[t][0], sl[t][1]), fmaxf(sl[t][2], sl[t][3])), mx);
                mx = fmaxf(mx, __shfl_xor(mx, 16)); mx = fmaxf(mx, __shfl_xor(mx, 32));
                float sum = 0.f;
#pragma unroll
                for (int t = 0; t < 16; ++t)
#pragma unroll
                    for (int e = 0; e < 4; ++e) { const float p = __builtin_amdgcn_exp2f(sl[t][e] - mx); sl[t][e] = p; sum += p; }
                m_run = mx; l_run = sum;
                const bf16* vb0 = VT + (((size_t)(b * 16 + head) * 128 + rs) * 64 + fr) * 64 + kc0 + 8 * fq;
#pragma unroll
                for (int hb = 0; hb < 4; ++hb) {
                    bf16x8 vfr[2][4];
#pragma unroll
                    for (int i = 0; i < 2; ++i)
#pragma unroll
                        for (int dt = 0; dt < 4; ++dt) vfr[i][dt] = *(const bf16x8*)(vb0 + (size_t)(2 * hb + i) * 4096 + dt * 16 * 64);
#pragma unroll
                    for (int i4 = 0; i4 < 2; ++i4) { const int i = 2 * hb + i4; v4u pw; pw.x = pk2(sl[2 * i][0], sl[2 * i][1]); pw.y = pk2(sl[2 * i][2], sl[2 * i][3]); pw.z = pk2(sl[2 * i + 1][0], sl[2 * i + 1][1]); pw.w = pk2(sl[2 * i + 1][2], sl[2 * i + 1][3]);
                        const bf16x8 pf = __builtin_bit_cast(bf16x8, pw);
#pragma unroll
                        for (int dt = 0; dt < 4; ++dt) oacc[dt] = MFMA16(vfr[i4][dt], pf, oacc[dt]); } }
            }
            {
                f32x4 sx[16];
#pragma unroll
                for (int s8 = 0; s8 < 8; ++s8)
#pragma unroll
                    for (int tb = 0; tb < 2; ++tb) { const int key = 32 * s8 + kcol + 4 * tb; f32x4 a = {0.f, 0.f, 0.f, 0.f};
#pragma unroll
                        for (int ks = 0; ks < 2; ++ks) { const bf16x8 kf = *(const LAS bf16x8*)(L + CK + key * 128 + (((ks * 4 + fq) ^ na_f(key)) << 4)); a = MFMA16(kf, qf[ks], a); }
                        sx[s8 * 2 + tb] = a; }
                float mx = -1e30f;
#pragma unroll
                for (int t = 0; t < 16; ++t) mx = fmaxf(fmaxf(fmaxf(sx[t][0], sx[t][1]), fmaxf(sx[t][2], sx[t][3])), mx);
                mx = fmaxf(mx, __shfl_xor(mx, 16)); mx = fmaxf(mx, __shfl_xor(mx, 32));
                const float mnew = fmaxf(mx, m_run), alpha = __builtin_amdgcn_exp2f(m_run - mnew);
#pragma unroll
                for (int dt = 0; dt < 4; ++dt) oacc[dt] = oacc[dt] * alpha;
                float sum = l_run * alpha;
#pragma unroll
                for (int t = 0; t < 16; ++t)
#pragma unroll
                    for (int e = 0; e < 4; ++e) { const float p = __builtin_amdgcn_exp2f(sx[t][e] - mnew); sx[t][e] = p; sum += p; }
                l_run = sum;
#pragma unroll
                for (int s8 = 0; s8 < 8; ++s8) { v4u pw; pw.x = pk2(sx[2 * s8][0], sx[2 * s8][1]); pw.y = pk2(sx[2 * s8][2], sx[2 * s8][3]); pw.z = pk2(sx[2 * s8 + 1][0], sx[2 * s8 + 1][1]); pw.w = pk2(sx[2 * s8 + 1][2], sx[2 * s8 + 1][3]);
                    const bf16x8 pf = __builtin_bit_cast(bf16x8, pw);
#pragma unroll
                    for (int dt = 0; dt < 4; ++dt) { const int d = 16 * dt + fr; const bf16x8 vf = *(const LAS bf16x8*)(L + CV + d * 512 + (((4 * s8 + fq) ^ fr) << 4)); oacc[dt] = MFMA16(vf, pf, oacc[dt]); } }
            }
            l_run += __shfl_xor(l_run, 16); l_run += __shfl_xor(l_run, 32);
            const float inv = 1.0f / l_run;
#pragma unroll
            for (int dt = 0; dt < 4; ++dt) { v2u w; w.x = pk2(oacc[dt][0] * inv, oacc[dt][1] * inv); w.y = pk2(oacc[dt][2] * inv, oacc[dt][3] * inv);
                *(v2u*)(O + (size_t)qtok * D + head * 64 + 16 * dt + 4 * fq) = w; }
            __syncthreads();
            if (loaded_hi + 1 <= next_hi) *(LAS v4u*)(L + KW + ((loaded_hi + 1) % 9) * 8192 + skey * 128 + ((sc ^ na_f(skey)) << 4)) = pre0;
            if (loaded_hi + 2 <= next_hi) *(LAS v4u*)(L + KW + ((loaded_hi + 2) % 9) * 8192 + skey * 128 + ((sc ^ na_f(skey)) << 4)) = pre1;
            loaded_hi = next_hi;
        }
    }
}

__device__ __forceinline__ size_t scan_tokbase2(int s, int b, int dir) { if (s < 2) return (size_t)TLAT + b * CTXL + (dir ? 1 - s : s) * 128; return (size_t)b * SEQ + (dir ? 63 - (s - 2) : s - 2) * 128; }
__device__ __forceinline__ size_t scan_tokbase(int s, int b, int dir) { if (s < 4) return (size_t)TLAT + b * CTXL + (dir ? 3 - s : s) * 64; return (size_t)b * SEQ + (dir ? 127 - (s - 4) : s - 4) * 64; }
#define ML_GATE_SCAN(G_U) do { LAS float* g_u_ = (G_U); LAS float* g_M_ = g_u_ + L; LAS float* g_in_ = g_M_ + L; LAS float* g_em_ = g_in_ + L; LAS float* g_w_ = g_em_ + L; LAS float* g_dec_ = g_w_ + L; \
                const float lf0 = fminf(rgf[0], 0.f) - log1pf(__expf(-fabsf(rgf[0]))), lf1 = fminf(rgf[1], 0.f) - log1pf(__expf(-fabsf(rgf[1]))); \
                float b0 = lf0, b1 = lf1; \
                _Pragma("unroll") for (int o = 1; o < 64; o <<= 1) { const float t0 = __shfl_up(b0, o), t1 = __shfl_up(b1, o); if (F.lane >= o) { b0 += t0; b1 += t1; } } \
                b1 += __shfl(b0, 63); \
                const float u0 = rgi[0] - b0, u1 = rgi[1] - b1; float c0 = u0, c1 = u1; \
                _Pragma("unroll") for (int o = 1; o < 64; o <<= 1) { const float t0 = __shfl_up(c0, o), t1 = __shfl_up(c1, o); if (F.lane >= o) { c0 = fmaxf(c0, t0); c1 = fmaxf(c1, t1); } } \
                c1 = fmaxf(c1, __shfl(c0, 63)); \
                const float M0 = fmaxf(m_st, c0), M1 = fmaxf(m_st, c1); \
                const float Ml = __shfl(M1, 63), bl = __shfl(b1, 63); \
                g_u_[F.lane] = u0; g_u_[F.lane + 64] = u1; g_M_[F.lane] = M0; g_M_[F.lane + 64] = M1; g_in_[F.lane] = fexp(m_st - M0); g_in_[F.lane + 64] = fexp(m_st - M1); \
                g_em_[F.lane] = fexp(-b0 - M0); g_em_[F.lane + 64] = fexp(-b1 - M1); g_w_[F.lane] = fexp(u0 - Ml); g_w_[F.lane + 64] = fexp(u1 - Ml); \
                if (F.lane == 0) g_dec_[0] = fexp(m_st - Ml); \
                m_st = bl + Ml; } while (0)
#define ML_GATE_LOAD(SIDX) do { const size_t tg_ = scan_tokbase2((SIDX), b, dir); _Pragma("unroll") for (int h2 = 0; h2 < 2; ++h2) { const size_t tk = tg_ + (dir ? 127 - (F.lane + 64 * h2) : F.lane + 64 * h2); rgi[h2] = Gt[tk * 32 + dir * 16 + head]; rgf[h2] = Gt[tk * 32 + dir * 16 + 8 + head]; } } while (0)
__device__ __forceinline__ void scan_phase(const Frame& F0, const bf16* P, const float* Gt, bf16* HD, const float* ROPE) {
    Frame F = F0; asm volatile("" : "+v"(F.tid)); F.lane = F.tid & 63;
    constexpr int LS = 72, LT = 136, L = 128, NSTEP = 66;
    LAS bf16* Qs = (LAS bf16*)(F.lds);
    LAS bf16* Ks = Qs + L * LS;
    LAS bf16* VTs = Ks + L * LS;
    LAS bf16* KwT = VTs + 80 * LT;
    LAS bf16* As = KwT + 64 * LT;
    LAS bf16* CT0 = As + L * LT;
    LAS bf16* CT1 = CT0 + 80 * LS;
    LAS float* gbase = (LAS float*)(CT1 + 80 * LS);
    constexpr int GSET = 5 * L + 4;
    const int fr = F.lane & 15, fq = F.lane >> 4;
    const int soff = F.tid >> 3, seg = F.tid & 7;
    for (int unit = blockIdx.x; unit < 256; unit += F.G) {
        const int b = unit >> 5, head = (unit >> 2) & 7, dir = (unit >> 1) & 1, vh = unit & 1;
        for (int i = F.tid; i < 80 * LT; i += NTHREADS) { if (i < 80 * LS) CT0[i] = 0; if (i >= 64 * LT) VTs[i] = (i < 65 * LT) ? (bf16)0x3F80u : (bf16)0; }
        f32x4 st[3];
#pragma unroll
        for (int x = 0; x < 3; ++x) st[x] = (f32x4){0.f, 0.f, 0.f, 0.f};
        float m_st = 0.f;
        v4u rq_[2], rk_[2], rv_[2]; float rgi[2] = {0.f, 0.f}, rgf[2] = {0.f, 0.f};
        { const size_t tb = scan_tokbase2(0, b, dir);
#pragma unroll
          for (int h2 = 0; h2 < 2; ++h2) { const bf16* pr = P + (tb + soff + 64 * h2) * 3072;
              rq_[h2] = *(const v4u*)(pr + head * 64 + seg * 8); rk_[h2] = *(const v4u*)(pr + 512 + head * 64 + seg * 8); rv_[h2] = *(const v4u*)(pr + 1024 + head * 128 + vh * 64 + seg * 8);
 } }
        if (F.wave == 0) { ML_GATE_LOAD(0); ML_GATE_SCAN(gbase); ML_GATE_LOAD(1); }
        __syncthreads();
        for (int s = 0; s < NSTEP; ++s) {
            LAS bf16* CTc = (s & 1) ? CT1 : CT0; LAS bf16* CTn = (s & 1) ? CT0 : CT1;
            const bool latent = s >= 2; const int cidx = latent ? (dir ? 63 - (s - 2) : s - 2) : 0;
            const size_t tb = scan_tokbase2(s, b, dir);
            LAS float* g_u = gbase + (s & 1) * GSET; LAS float* g_M = g_u + L; LAS float* g_in = g_M + L; LAS float* g_em = g_in + L; LAS float* g_w = g_em + L; LAS float* g_dec = g_w + L;
            float kv[2][8];
#pragma unroll
            for (int h2 = 0; h2 < 2; ++h2) { const int off = soff + 64 * h2, tau = dir ? 127 - off : off;
              float qv[8]; const unsigned qw[4] = {rq_[h2].x, rq_[h2].y, rq_[h2].z, rq_[h2].w}, kw[4] = {rk_[h2].x, rk_[h2].y, rk_[h2].z, rk_[h2].w};
#pragma unroll
              for (int e = 0; e < 4; ++e) { qv[2 * e] = bflo(qw[e]); qv[2 * e + 1] = bfhi(qw[e]); kv[h2][2 * e] = bflo(kw[e]); kv[h2][2 * e + 1] = bfhi(kw[e]); }
              if (latent) {
                  const int pos = (seg < 4) ? (2 * cidx + h2) : soff; const float* ct = ROPE + pos * 16 + (seg & 1) * 8; const float sgn = (seg & 2) ? 1.0f : -1.0f;
                  const f32x4 c0 = *(const f32x4*)(ct), c1 = *(const f32x4*)(ct + 4), s0 = *(const f32x4*)(ct + 2048), s1 = *(const f32x4*)(ct + 2052);
#pragma unroll
                  for (int e = 0; e < 8; ++e) { const float cs = e < 4 ? c0[e] : c1[e - 4], sn = (e < 4 ? s0[e] : s1[e - 4]) * sgn;
                      const float qp = __shfl_xor(qv[e], 2), kp = __shfl_xor(kv[h2][e], 2);
                      qv[e] = qv[e] * cs + qp * sn; kv[h2][e] = kv[h2][e] * cs + kp * sn; }
              }
              v4u qo, ko; qo.x = pk2(qv[0], qv[1]); qo.y = pk2(qv[2], qv[3]); qo.z = pk2(qv[4], qv[5]); qo.w = pk2(qv[6], qv[7]);
              ko.x = pk2(kv[h2][0], kv[h2][1]); ko.y = pk2(kv[h2][2], kv[h2][3]); ko.z = pk2(kv[h2][4], kv[h2][5]); ko.w = pk2(kv[h2][6], kv[h2][7]);
              *(LAS v4u*)(Qs + tau * LS + seg * 8) = qo; *(LAS v4u*)(Ks + tau * LS + seg * 8) = ko;
              kv[h2][0] = bflo(ko.x); kv[h2][1] = bfhi(ko.x); kv[h2][2] = bflo(ko.y); kv[h2][3] = bfhi(ko.y); kv[h2][4] = bflo(ko.z); kv[h2][5] = bfhi(ko.z); kv[h2][6] = bflo(ko.w); kv[h2][7] = bfhi(ko.w);
              const unsigned vw[4] = {rv_[h2].x, rv_[h2].y, rv_[h2].z, rv_[h2].w};
              const int tsw = (((tau >> 3) ^ seg) << 3) | (tau & 7);
#pragma unroll
              for (int e = 0; e < 4; ++e) { VTs[(seg * 8 + 2 * e) * LT + tsw] = (bf16)(vw[e] & 0xffffu); VTs[(seg * 8 + 2 * e + 1) * LT + tsw] = (bf16)(vw[e] >> 16); }
            }
            __syncthreads();
#pragma unroll
            for (int h2 = 0; h2 < 2; ++h2) { const int off = soff + 64 * h2, tau = dir ? 127 - off : off; const float w = g_w[tau];
#pragma unroll
              for (int e = 0; e < 8; ++e) KwT[(seg * 8 + e) * LT + ((((tau >> 3) ^ seg) << 3) | (tau & 7))] = (bf16)f2bf(kv[h2][e] * w); }
            if (s + 1 < NSTEP) { const size_t tn = scan_tokbase2(s + 1, b, dir);
#pragma unroll
                for (int h2 = 0; h2 < 2; ++h2) { const bf16* pr = P + (tn + soff + 64 * h2) * 3072;
                    rq_[h2] = *(const v4u*)(pr + head * 64 + seg * 8); rk_[h2] = *(const v4u*)(pr + 512 + head * 64 + seg * 8); rv_[h2] = *(const v4u*)(pr + 1024 + head * 128 + vh * 64 + seg * 8);
 } }
            if (F.wave == 0 && s + 1 < NSTEP) { ML_GATE_SCAN(gbase + ((s + 1) & 1) * GSET); if (s + 2 < NSTEP) ML_GATE_LOAD(s + 2); }
            { int n = 0;
#pragma unroll
              for (int tt = 0; tt < 8; ++tt)
#pragma unroll
                  for (int sg = 0; sg <= tt; ++sg, ++n) if ((n % 7) + 1 == F.wave) {
                      const int tq = 16 * tt + fr, sg0 = 16 * sg + 4 * fq; f32x4 a = {0.f, 0.f, 0.f, 0.f};
#pragma unroll
                      for (int ks = 0; ks < 2; ++ks) { const bf16x8 kf = *(const LAS bf16x8*)(Ks + (16 * sg + fr) * LS + ks * 32 + fq * 8), qf = *(const LAS bf16x8*)(Qs + (16 * tt + fr) * LS + ks * 32 + fq * 8); a = MFMA16(kf, qf, a); }
                      const float Mt = g_M[tq]; float av[4];
#pragma unroll
                      for (int e = 0; e < 4; ++e) { const int sig = sg0 + e; av[e] = (sig <= tq) ? a[e] * fexp(g_u[sig] - Mt) : 0.f; }
                      v2u w; w.x = pk2(av[0], av[1]); w.y = pk2(av[2], av[3]);
                      *(LAS v2u*)(As + tq * LT + sg0) = w;
                      if (sg == tt && (tt & 1) == 0) *(LAS v2u*)(As + tq * LT + sg0 + 16) = (v2u){0u, 0u};
                  } }
            __syncthreads();
            { const int tt = F.wave; const int tq = 16 * tt + fr;
              f32x4 acc[5];
#pragma unroll
              for (int x = 0; x < 5; ++x) acc[x] = (f32x4){0.f, 0.f, 0.f, 0.f};
#pragma unroll
              for (int ks = 0; ks < 2; ++ks) { const bf16x8 qf = *(const LAS bf16x8*)(Qs + tq * LS + ks * 32 + fq * 8);
#pragma unroll
                  for (int x = 0; x < 5; ++x) { const bf16x8 cf = *(const LAS bf16x8*)(CTc + (16 * x + fr) * LS + ks * 32 + fq * 8); acc[x] = MFMA16(cf, qf, acc[x]); } }
              const float it = g_in[tq];
#pragma unroll
              for (int x = 0; x < 5; ++x) acc[x] = acc[x] * it;
              for (int ks = 0; ks <= (tt >> 1); ++ks) { const bf16x8 af = *(const LAS bf16x8*)(As + tq * LT + ks * 32 + fq * 8);
#pragma unroll
                  for (int x = 0; x < 5; ++x) { const bf16x8 vf = *(const LAS bf16x8*)(VTs + (16 * x + fr) * LT + (((ks * 4 + fq) ^ ((2 * x + (fr >> 3)) & 7)) << 3)); acc[x] = MFMA16(vf, af, acc[x]); } }
              const float den = __shfl(acc[4][0], fr);
              const float rden = 1.0f / fmaxf(fabsf(den), g_em[tq]);
              const int off = dir ? 127 - tq : tq;
              bf16* orow = HD + ((size_t)dir * TT + tb + off) * D + head * 128 + vh * 64 + 4 * fq;
#pragma unroll
              for (int x = 0; x < 4; ++x) { v2u w; w.x = pk2(acc[x][0] * rden, acc[x][1] * rden); w.y = pk2(acc[x][2] * rden, acc[x][3] * rden); *(v2u*)(orow + 16 * x) = w; }
            }
            { const int dt = F.wave & 3, eh = F.wave >> 2; const float dec = g_dec[0];
#pragma unroll
              for (int x = 0; x < 3; ++x) { if (x == 2 && eh != 0) continue; const int et = (x < 2) ? 2 * eh + x : 4;
                  st[x] = st[x] * dec;
#pragma unroll
                  for (int ks = 0; ks < 4; ++ks) { const bf16x8 vf = *(const LAS bf16x8*)(VTs + (16 * et + fr) * LT + (((ks * 4 + fq) ^ ((2 * et + (fr >> 3)) & 7)) << 3)), kf = *(const LAS bf16x8*)(KwT + (16 * dt + fr) * LT + (((ks * 4 + fq) ^ ((2 * dt + (fr >> 3)) & 7)) << 3)); st[x] = MFMA16(vf, kf, st[x]); }
#pragma unroll
                  for (int e = 0; e < 4; ++e) CTn[(16 * et + 4 * fq + e) * LS + 16 * dt + fr] = (bf16)f2bf(st[x][e]); } }
            __syncthreads();
        }
    }
}
__device__ __forceinline__ void readout_phase(const Frame& F0, int M, const bf16* HD, const bf16* P, const float* ng, bf16* H) {
    Frame F = F0; asm volatile("" : "+v"(F.tid)); F.lane = F.tid & 63;
    for (int r = F.gw; r < M; r += F.NGW) {
        const int c = 16 * F.lane;
        const v4u f0 = *(const v4u*)(HD + (size_t)r * D + c), f1 = *(const v4u*)(HD + (size_t)r * D + c + 8);
        const v4u b0 = *(const v4u*)(HD + ((size_t)TT + r) * D + c), b1 = *(const v4u*)(HD + ((size_t)TT + r) * D + c + 8);
        const v4u o0 = *(const v4u*)(P + (size_t)r * 3072 + 2048 + c), o1 = *(const v4u*)(P + (size_t)r * 3072 + 2048 + c + 8);
        const unsigned fw[8] = {f0.x, f0.y, f0.z, f0.w, f1.x, f1.y, f1.z, f1.w}, bw[8] = {b0.x, b0.y, b0.z, b0.w, b1.x, b1.y, b1.z, b1.w}, ow[8] = {o0.x, o0.y, o0.z, o0.w, o1.x, o1.y, o1.z, o1.w};
        float h[16]; float ss = 0.f;
#pragma unroll
        for (int e = 0; e < 8; ++e) { h[2 * e] = bflo(fw[e]) + bflo(bw[e]); h[2 * e + 1] = bfhi(fw[e]) + bfhi(bw[e]); ss += h[2 * e] * h[2 * e] + h[2 * e + 1] * h[2 * e + 1]; }
        ss += __shfl_xor(ss, 1); ss += __shfl_xor(ss, 2); ss += __shfl_xor(ss, 4);
        const float rs = 1.0f / sqrtf(ss * (1.0f / 128.0f) + NORM_EPS);
        unsigned ww[8];
#pragma unroll
        for (int e = 0; e < 8; ++e) { const float oa = bflo(ow[e]), ob = bfhi(ow[e]);
            const float va = h[2 * e] * rs * ng[c + 2 * e] / (1.0f + __expf(-oa)), vb = h[2 * e + 1] * rs * ng[c + 2 * e + 1] / (1.0f + __expf(-ob)); ww[e] = pk2(va, vb); }
        *(v4u*)(H + (size_t)r * D + c) = (v4u){ww[0], ww[1], ww[2], ww[3]}; *(v4u*)(H + (size_t)r * D + c + 8) = (v4u){ww[4], ww[5], ww[6], ww[7]};
    }
}

#ifndef DUPG
#define DUPG 1
#endif
#ifndef DUPNA
#define DUPNA 1
#endif
#ifndef DUPSCAN
#define DUPSCAN 1
#endif
#define REP_G for (int rep_ = 0; rep_ < DUPG; ++rep_)
#define REP_NA for (int rep_ = 0; rep_ < DUPNA; ++rep_)
#define REP_SCAN for (int rep_ = 0; rep_ < DUPSCAN; ++rep_)
#ifndef DUPMISC
#define DUPMISC 1
#endif
#ifndef DUPMIX
#define DUPMIX 1
#endif
#ifndef DUPBAR
#define DUPBAR 1
#endif
#ifndef STAG
#define STAG 0
#endif
#ifndef DUPF1
#define DUPF1 1
#endif
#ifndef DUPF2
#define DUPF2 1
#endif
#define REP_F1 for (int rep_ = 0; rep_ < DUPF1; ++rep_)
#define REP_F2 for (int rep_ = 0; rep_ < DUPF2; ++rep_)
#define REP_MISC for (int rep_ = 0; rep_ < DUPMISC; ++rep_)

struct Args { const float* in[25]; float* out; unsigned char* ws; };
__global__ void __launch_bounds__(NTHREADS, 2) fwd_kernel(Args args) {
    extern __shared__ __attribute__((aligned(16))) unsigned char lds_raw[];
    Frame F;
    F.lds = (LAS unsigned char*)lds_raw;
    F.tid = threadIdx.x; F.lane = F.tid & 63; F.wave = __builtin_amdgcn_readfirstlane(F.tid >> 6);
    F.G = gridDim.x; F.gw = blockIdx.x * NWAVES + F.wave; F.NGW = F.G * NWAVES;
#pragma unroll
    for (int i = 0; i < 25; ++i) F.in[i] = args.in[i];
    F.out = args.out; F.ws = args.ws;
    unsigned char* ws = args.ws;
    for (int u = F.tid; u < (LDS_BYTES - LDSCTL_OFF) / 4; u += NTHREADS) ((LAS unsigned*)(F.lds + LDSCTL_OFF))[u] = 0u;
    __syncthreads();
    XcdBarrier bar = xcd_barrier_post((unsigned*)(ws + WS_CTL) + CW_BAR, (volatile LAS unsigned*)(F.lds + MISC_OFF) + 8);
#define GRID_BAR() do { for (int rb_ = 0; rb_ < DUPBAR; ++rb_) xcd_barrier(bar); } while (0)
    float* MODS = (float*)(ws + WS_MODS);
    bf16* WA = (bf16*)(ws + WS_WA); bf16* WB = (bf16*)(ws + WS_WB);
    bf16* HBUF = (bf16*)F.out;
    bf16* X16 = (bf16*)(ws + WS_HBUF);
    bf16* Y = (bf16*)(ws + WS_Y); float* PART = (float*)(ws + WS_Y + 132 * MiB);
    float* ST = (float*)(ws + WS_STATS);
    const float* norm_g = F.in[6];
    LAS unsigned char* ring = F.lds + RING_OFF;

    REP_MISC { mods_phase(F);
    convert_layer(F, 0, WA);
    convert_layer(F, 1, WB); }
    GRID_BAR();
    REP_MISC row_phase<false, true, false, false>(F, TT, F.in[0], F.in[2], nullptr, nullptr, nullptr, nullptr, nullptr, nullptr, norm_g, MODS + 1024, MODS, HBUF);
    GRID_BAR();

    for (int layer = 0; layer < DEPTH; ++layer) {
        const int kind = layer % 3, j = layer / 3, M = (layer == DEPTH - 1) ? TLAT : TT;
        const int M2 = (layer >= DEPTH - 2) ? TLAT : TT;
        bf16* WR = (layer & 1) ? WB : WA;
        const float* mods_l = MODS + (size_t)layer * 9 * 6144;
        if (kind == 0) {
            bf16* U = (bf16*)(ws + WS_GM_U); bf16* VT = (bf16*)(ws + WS_GM_VT);
            const float* b_in = F.in[10] + (size_t)j * 6144;
            REP_G { pg8::Gemm g{HBUF, WR + WO_GM_IN, M, GH, D, D, 0}; pg8::StaticOrder S; S.init(M, GH, F.G, (int)blockIdx.x);
              pg8::EpiBf16<1> E{U, GH, b_in, 0, 0, 1.f};
              pg8::gemm_phase<pg8::EpiBf16<1>, pg8::StaticOrder, true, true>(ring, g, S, E, STAG); }
            REP_G { pg8::Gemm g{WR + WO_GM_IN + (size_t)GH * D, HBUF, GH, M, D, D, 0}; pg8::StaticOrder S; S.init(GH, M, F.G, (int)blockIdx.x);
              pg8::EpiSwap<1, 0, true> E{VT, b_in + GH, ST};
              pg8::gemm_phase<pg8::EpiSwap<1, 0, true>, pg8::StaticOrder, true, true>(ring, g, S, E, STAG); }
            GRID_BAR();
            for (int rep_ = DUPMIX - 1; rep_ >= 0; --rep_) mix_phase(F, rep_ != 0 && ((const unsigned*)(ws + WS_CTL))[8] == 0u, M / 128, VT, U, ST, F.in[12] + (size_t)j * 8 * 128 * 128, F.in[13] + (size_t)j * 8 * 128, F.in[11] + (size_t)j * GH);
            GRID_BAR();
            REP_G { pg8::Gemm g{U, WR + WO_GM_OUT, TLAT, D, GH, GH, 0}; pg8::StaticOrder S; S.init(TLAT, D, F.G, (int)blockIdx.x);
              pg8::EpiBf16<0, false> E{Y, D, nullptr, 0, 0, 1.f};
              pg8::gemm_phase<pg8::EpiBf16<0, false>, pg8::StaticOrder, true, true>(ring, g, S, E); }
            if (M == TT) { pg8::Gemm g{U + (size_t)TLAT * GH, WR + WO_GM_OUT, TCTX, D, GH, GH / 8, (size_t)(GH / 8) * 2}; pg8::SplitOrder S; S.init(8, F.G, (int)blockIdx.x);
              pg8::EpiF32P E{PART};
              pg8::gemm_phase<pg8::EpiF32P, pg8::SplitOrder, true, true>(ring, g, S, E); }
            GRID_BAR();
        } else if (kind == 1) {
            bf16* Q = (bf16*)(ws + WS_NA_Q); bf16* Kb = (bf16*)(ws + WS_NA_K); bf16* VT = (bf16*)(ws + WS_NA_VT); bf16* O = (bf16*)(ws + WS_NA_O);
            const float* b_qkv = F.in[16];
            REP_G { pg8::Gemm g{HBUF, WR + WO_NA_QKV, M, 2048, D, D, 0}; pg8::StaticOrder S; S.init(M, 2048, F.G, (int)blockIdx.x);
              pg8::EpiBf16<0> E{Q, D, b_qkv, 1024, (size_t)(WS_NA_K - WS_NA_Q) / 2, 0.125f * 1.4426950408889634f};
              pg8::gemm_phase<pg8::EpiBf16<0>, pg8::StaticOrder, true, true>(ring, g, S, E, STAG); }
            REP_G { pg8::Gemm g{WR + WO_NA_QKV + (size_t)2048 * D, HBUF, D, M, D, D, 0}; pg8::StaticOrder S; S.init(D, M, F.G, (int)blockIdx.x);
              pg8::EpiSwap<0, 1, false> E{VT, b_qkv + 2048, nullptr};
              pg8::gemm_phase<pg8::EpiSwap<0, 1, false>, pg8::StaticOrder, true, true>(ring, g, S, E); }
            GRID_BAR();
            REP_NA na_phase(F, Q, Kb, VT, O, F.in[17]);
            GRID_BAR();
            REP_G { pg8::Gemm g{O, WR + WO_NA_O, TLAT, D, D, D, 0}; pg8::StaticOrder S; S.init(TLAT, D, F.G, (int)blockIdx.x);
              pg8::EpiBf16<0> E{Y, D, F.in[19], 0, 0, 1.f};
              pg8::gemm_phase<pg8::EpiBf16<0>, pg8::StaticOrder, true, true>(ring, g, S, E); }
            { pg8::Gemm g{O + (size_t)TLAT * D, WR + WO_NA_O, TCTX, D, D, D / 4, (size_t)(D / 4) * 2}; pg8::SplitOrder S; S.init(4, F.G, (int)blockIdx.x);
              pg8::EpiF32P E{PART};
              pg8::gemm_phase<pg8::EpiF32P, pg8::SplitOrder, true, true>(ring, g, S, E); }
            GRID_BAR();
        } else {
            bf16* P = (bf16*)(ws + WS_ML_P); float* Gt = (float*)(ws + WS_ML_G); bf16* HD = (bf16*)(ws + WS_ML_HD);
            REP_G { pg8::Gemm g{HBUF, WR + WO_ML_IN, M, 3328, D, D, 0}; pg8::StaticOrder S; S.init(M, 3328, F.G, (int)blockIdx.x);
              pg8::EpiMl E{P, Gt, F.in[22]};
              pg8::gemm_phase<pg8::EpiMl, pg8::StaticOrder, true, true>(ring, g, S, E, STAG); }
            GRID_BAR();
            REP_SCAN scan_phase(F, P, Gt, HD, (const float*)(ws + WS_ROPE));
            GRID_BAR();
            REP_MISC readout_phase(F, M2, HD, P, F.in[23], HBUF);
            GRID_BAR();
            REP_G { pg8::Gemm g{HBUF, WR + WO_ML_OUT, M2, D, D, D, 0}; pg8::StaticOrder S; S.init(M2, D, F.G, (int)blockIdx.x);
              pg8::EpiBf16<0, false> E{Y, D, nullptr, 0, 0, 1.f};
              pg8::gemm_phase<pg8::EpiBf16<0, false>, pg8::StaticOrder, true, true>(ring, g, S, E); }
            GRID_BAR();
        }
        if (layer == 0) row_phase<true, true, false, true>(F, M2, F.in[0], F.in[2], nullptr, nullptr, X16, Y, norm_g + ((size_t)layer * 4 + 1) * D, mods_l + 2 * 1024,
                              norm_g + ((size_t)layer * 4 + 2) * D, mods_l + 4 * 1024, mods_l + 3 * 1024, HBUF, PART, 8, nullptr);
        else row_phase<true, true, true, true>(F, M2, nullptr, nullptr, X16, nullptr, X16, Y, norm_g + ((size_t)layer * 4 + 1) * D, mods_l + 2 * 1024,
                              norm_g + ((size_t)layer * 4 + 2) * D, mods_l + 4 * 1024, mods_l + 3 * 1024, HBUF, PART, 4, kind == 1 ? F.in[19] : nullptr);
        GRID_BAR();
        const size_t o_w1 = kind == 0 ? WO_GM_W1 : kind == 1 ? WO_NA_W1 : WO_ML_W1, o_w2 = kind == 0 ? WO_GM_W2 : kind == 1 ? WO_NA_W2 : WO_ML_W2;
        { bf16* HID = (bf16*)(ws + WS_HID);
          REP_F1 { pg8::Gemm g{HBUF, WR + o_w1, M2, FF, D, D, 0}; pg8::StaticOrder S; S.init(M2, FF, F.G, (int)blockIdx.x);
            pg8::EpiBf16<2, false> E{HID, FF, nullptr, 0, 0, 1.f};
            pg8::gemm_phase<pg8::EpiBf16<2, false>, pg8::StaticOrder, true, true>(ring, g, S, E, STAG); }
          GRID_BAR();
          REP_F2 { pg8::Gemm g{HID, WR + o_w2, TLAT, D, FF, FF, 0}; pg8::StaticOrder S; S.init(TLAT, D, F.G, (int)blockIdx.x);
            pg8::EpiBf16<0, false> E{Y, D, nullptr, 0, 0, 1.f};
            pg8::gemm_phase<pg8::EpiBf16<0, false>, pg8::StaticOrder, true, true>(ring, g, S, E); }
          if (M2 == TT) { pg8::Gemm g{HID + (size_t)TLAT * FF, WR + o_w2, TCTX, D, FF, FF / 8, (size_t)(FF / 8) * 2}; pg8::SplitOrder S; S.init(8, F.G, (int)blockIdx.x);
            pg8::EpiF32P E{PART};
            pg8::gemm_phase<pg8::EpiF32P, pg8::SplitOrder, true, true>(ring, g, S, E); }
          GRID_BAR(); }
        if (layer < DEPTH - 1) {
            const float* mods_n = MODS + (size_t)(layer + 1) * 9 * 6144;
            const int Mn = (layer + 1 == DEPTH - 1) ? TLAT : TT;
            row_phase<true, true, true, true>(F, Mn, nullptr, nullptr, X16, nullptr, X16, Y, norm_g + ((size_t)layer * 4 + 3) * D, mods_l + 5 * 1024,
                                  norm_g + ((size_t)(layer + 1) * 4 + 0) * D, mods_n + 1 * 1024, mods_n + 0 * 1024, HBUF, PART, 8, nullptr);
            if (layer + 2 < DEPTH) convert_layer(F, layer + 2, WR);
            GRID_BAR();
        } else {
            row_phase<true, false, true, false>(F, TLAT, nullptr, nullptr, X16, F.out, nullptr, Y, norm_g + ((size_t)layer * 4 + 3) * D, mods_l + 5 * 1024, nullptr, nullptr, nullptr, nullptr);
        }
    }
}

extern "C" void kernel_launch(void* const* d_in, const int* in_sizes, int n_in, void* d_out, int out_size, void* d_ws, size_t ws_size, hipStream_t stream) {
    static int grid = 0;
    if (grid == 0) {
        if (n_in != 25 || out_size != TLAT * D || ws_size < WS_NEED) { fprintf(stderr, "kernel_launch: unexpected shapes: n_in %d out %d ws %zu (need %zu)\n", n_in, out_size, ws_size, (size_t)WS_NEED); grid = -1; return; }
        int dev = 0, cus = 0, per_cu = 0;
        if (hipGetDevice(&dev) != hipSuccess || hipDeviceGetAttribute(&cus, hipDeviceAttributeMultiprocessorCount, dev) != hipSuccess) { grid = -1; return; }
        if (hipFuncSetAttribute((const void*)fwd_kernel, hipFuncAttributeMaxDynamicSharedMemorySize, LDS_BYTES) != hipSuccess) { fprintf(stderr, "kernel_launch: hipFuncSetAttribute failed\n"); grid = -1; return; }
        if (hipOccupancyMaxActiveBlocksPerMultiprocessor(&per_cu, (const void*)fwd_kernel, NTHREADS, LDS_BYTES) != hipSuccess || per_cu < 1)
            fprintf(stderr, "kernel_launch: occupancy query reports %d workgroups per CU\n", per_cu);
        (void)hipGetLastError();
        grid = cus;
    }
    if (grid < 0) return;
    if (hipMemsetAsync((char*)d_ws + WS_CTL, 0, CTL_ZERO_BYTES, stream) != hipSuccess) return;
    Args a{};
    for (int i = 0; i < 25; ++i) a.in[i] = (const float*)d_in[i];
    a.out = (float*)d_out; a.ws = (unsigned char*)d_ws;
    hipLaunchKernelGGL(fwd_kernel, dim3(grid), dim3(NTHREADS), LDS_BYTES, stream, a);
}
```

```cpp
#include <hip/hip_runtime.h>
#include <cstdio>
#include <cstdint>
namespace pg8 {
#define PG8_LAS __attribute__((address_space(3)))
typedef unsigned short bf16_t;
typedef short bf16x8 __attribute__((ext_vector_type(8)));
typedef float f32x4 __attribute__((ext_vector_type(4)));
typedef unsigned u32x4 __attribute__((ext_vector_type(4)));
constexpr int BM = 256, BK = 64, HALF = 128, HTB = HALF * BK * 2  , STAGE_BYTES = 8 * HTB, NXCD = 8, WGM = 8;

__host__ __device__ __forceinline__ int lds_byte(int r, int c) { const int st = (r >> 4) * 2 + (c >> 5), rr = r & 15, cc = c & 31, ob = rr * 64 + cc * 2; return st * 1024 + (ob ^ (((ob >> 9) & 1) << 5)); }
__host__ __device__ __forceinline__ void stage_rc(int b, int& R, int& C) { const int st = b / 1024, sb = b % 1024, swz = sb ^ (((sb >> 9) & 1) << 5); R = (st >> 1) * 16 + swz / 64; C = (st & 1) * 32 + (swz % 64) / 2; }
__host__ __device__ __forceinline__ int perm32(int rho) { const int n = rho >> 4, i = rho & 15; return 8 * (i >> 2) + 4 * n + (i & 3); }

struct Unit { int pm, pn, pk; };
struct Gemm { const bf16_t* A; const bf16_t* Bt; int M, N, K; int Kloop; size_t kslice_bytes; };

struct StaticOrder {
    int nM, nN, nwg, G, c;
    __host__ __device__ void init(int M, int N, int G_, int c_) { nM = M / BM; nN = N / BM; nwg = nM * nN; G = G_; c = c_; }
    __host__ __device__ bool next(int i, Unit& u) const {
        const long L = (long)i * G + c; if (L >= nwg) return false;
        int wgid = (int)L; { const int q = nwg / NXCD, r = nwg % NXCD, xcd = wgid % NXCD, off = wgid / NXCD; wgid = (xcd < r ? xcd * (q + 1) : r * (q + 1) + (xcd - r) * q) + off; }
        const int nig = WGM * nN, gid = wgid / nig, fm = gid * WGM, gsz = (nM - fm) < WGM ? (nM - fm) : WGM;
        u.pm = fm + ((wgid % nig) % gsz); u.pn = (wgid % nig) / gsz; u.pk = 0; return true;
    }
    __device__ __forceinline__ void a_ready(const Unit&) const {}
    __device__ __forceinline__ void done(const Unit&) const {}
};
struct SplitOrder {
    int KP, G, c;
    __host__ __device__ void init(int KP_, int G_, int c_) { KP = KP_; G = G_; c = c_; }
    __host__ __device__ bool next(int i, Unit& u) const { const int L = i * G + c; if (L >= 32 * KP) return false; u.pm = L & 7; u.pn = (L >> 3) & 3; u.pk = L >> 5; return true; }
    __device__ __forceinline__ void a_ready(const Unit&) const {}
    __device__ __forceinline__ void done(const Unit&) const {}
};

typedef __bf16 bf16v2_t __attribute__((ext_vector_type(2))); typedef float f32x2_t __attribute__((ext_vector_type(2)));
__device__ __forceinline__ unsigned cvt_pk_bf16(float lo, float hi) { const f32x2_t v = {lo, hi}; const bf16v2_t b = __builtin_convertvector(v, bf16v2_t); return __builtin_bit_cast(unsigned, b); }
__device__ __forceinline__ float gelu_tanh(float x) {
    const float z = x * (1.0f + 0.044715f * x * x);
    return x * __builtin_amdgcn_rcpf(1.0f + __builtin_amdgcn_exp2f(-2.302208198f * z));
}
__device__ __forceinline__ f32x2_t gelu_tanh2(f32x2_t x) {
    const f32x2_t p = (x * x) * (0.044715f * -2.302208198f) + (-2.302208198f);
    const f32x2_t z = x * p;
    f32x2_t e; e.x = __builtin_amdgcn_exp2f(z.x); e.y = __builtin_amdgcn_exp2f(z.y);
    const f32x2_t d = e + 1.0f;
    f32x2_t r; r.x = __builtin_amdgcn_rcpf(d.x); r.y = __builtin_amdgcn_rcpf(d.y);
    return x * r;
}
template <int ACT> __device__ __forceinline__ f32x4 act4(f32x4 v) {
    if (ACT == 1) { const f32x2_t a = gelu_tanh2((f32x2_t){v[0], v[1]}), b = gelu_tanh2((f32x2_t){v[2], v[3]}); v = (f32x4){a.x, a.y, b.x, b.y}; }
    if (ACT == 2) { v[0] = fmaxf(v[0], 0.f); v[1] = fmaxf(v[1], 0.f); v[2] = fmaxf(v[2], 0.f); v[3] = fmaxf(v[3], 0.f); v = v * v; }
    return v;
}

template <int ACT, bool HAS_BIAS = true> struct EpiBf16 {
    static constexpr bool PERM = true, AFTER_DRAIN = false;
    bf16_t* O; int ldc; const float* bias; int split_cols; size_t split_stride; float scale0;
    __device__ __forceinline__ void operator()(const f32x4 (&acc)[2][2][4][2], const Unit& u, int wr, int wc, int fr, int fq) const {
        const int row0 = u.pm * BM + wr * 64 + fr; int colt = u.pn * BM; bf16_t* base = O;
        float sc = 1.f; if (split_cols) { const int t = colt / split_cols; base += (size_t)t * split_stride; colt -= t * split_cols; if (t == 0) sc = scale0; }
        const int col0 = colt + wc * 32 + 8 * fq, bcol0 = u.pn * BM + wc * 32 + 8 * fq;
        f32x4 bv[2][2];
#pragma unroll
        for (int bj = 0; bj < 2; ++bj)
#pragma unroll
            for (int n = 0; n < 2; ++n) bv[bj][n] = HAS_BIAS ? *(const f32x4*)(bias + bcol0 + bj * HALF + 4 * n) : (f32x4){0.f, 0.f, 0.f, 0.f};
#pragma unroll
        for (int ai = 0; ai < 2; ++ai)
#pragma unroll
            for (int m = 0; m < 4; ++m) { bf16_t* rowp = base + (size_t)(row0 + ai * HALF + m * 16) * ldc + col0;
#pragma unroll
                for (int bj = 0; bj < 2; ++bj) { f32x4 v0 = acc[ai][bj][m][0], v1 = acc[ai][bj][m][1]; if (HAS_BIAS) { v0 = v0 + bv[bj][0]; v1 = v1 + bv[bj][1]; } v0 = act4<ACT>(v0); v1 = act4<ACT>(v1);
                    if (split_cols) { v0 = v0 * sc; v1 = v1 * sc; } u32x4 w; w.x = cvt_pk_bf16(v0[0], v0[1]); w.y = cvt_pk_bf16(v0[2], v0[3]); w.z = cvt_pk_bf16(v1[0], v1[1]); w.w = cvt_pk_bf16(v1[2], v1[3]);
                    *(u32x4*)(rowp + bj * HALF) = w; } }
    }
};

struct EpiF32 {
    static constexpr bool PERM = false, AFTER_DRAIN = false;
    float* C; int ldc; const float* bias;
    __device__ __forceinline__ void operator()(const f32x4 (&acc)[2][2][4][2], const Unit& u, int wr, int wc, int fr, int fq) const {
        const int row0 = u.pm * BM + wr * 64 + fr, col0 = u.pn * BM + wc * 32 + 4 * fq;
        f32x4 bv[2][2];
#pragma unroll
        for (int bj = 0; bj < 2; ++bj)
#pragma unroll
            for (int n = 0; n < 2; ++n) bv[bj][n] = bias ? *(const f32x4*)(bias + col0 + bj * HALF + n * 16) : (f32x4){0.f, 0.f, 0.f, 0.f};
#pragma unroll
        for (int ai = 0; ai < 2; ++ai)
#pragma unroll
            for (int m = 0; m < 4; ++m) { float* rowp = C + (size_t)(row0 + ai * HALF + m * 16) * ldc + col0;
#pragma unroll
                for (int bj = 0; bj < 2; ++bj)
#pragma unroll
                    for (int n = 0; n < 2; ++n) *(f32x4*)(rowp + bj * HALF + n * 16) = acc[ai][bj][m][n] + bv[bj][n]; }
    }
};

struct EpiF32P {
    static constexpr bool PERM = false, AFTER_DRAIN = false;
    float* C;
    __device__ __forceinline__ void operator()(const f32x4 (&acc)[2][2][4][2], const Unit& u, int wr, int wc, int fr, int fq) const {
        const int row0 = u.pm * BM + wr * 64 + fr, col0 = u.pn * BM + wc * 32 + 4 * fq; float* base = C + (size_t)u.pk * (2048 * 1024);
#pragma unroll
        for (int ai = 0; ai < 2; ++ai)
#pragma unroll
            for (int m = 0; m < 4; ++m) { float* rowp = base + (size_t)(row0 + ai * HALF + m * 16) * 1024 + col0;
#pragma unroll
                for (int bj = 0; bj < 2; ++bj)
#pragma unroll
                    for (int n = 0; n < 2; ++n) *(f32x4*)(rowp + bj * HALF + n * 16) = acc[ai][bj][m][n]; }
    }
};

template <int MODE> struct EpiProbe {
    static constexpr bool PERM = true, AFTER_DRAIN = false;
    bf16_t* O; int ldc;
    __device__ __forceinline__ void operator()(const f32x4 (&acc)[2][2][4][2], const Unit& u, int wr, int wc, int fr, int fq) const {
        if (MODE == 0) { if (acc[0][0][0][0][0] == 1.2345e33f) O[0] = 1; return; }
        const int row0 = u.pm * BM + wr * 64 + fr, col0 = u.pn * BM + wc * 32 + 8 * fq;
        u32x4 keep = {0u, 0u, 0u, 0u};
#pragma unroll
        for (int ai = 0; ai < 2; ++ai)
#pragma unroll
            for (int m = 0; m < 4; ++m) { bf16_t* rowp = O + (size_t)(row0 + ai * HALF + m * 16) * ldc + col0;
#pragma unroll
                for (int bj = 0; bj < 2; ++bj) { f32x4 v0 = acc[ai][bj][m][0], v1 = acc[ai][bj][m][1];
                    if (MODE == 2) { v0 = act4<2>(v0); v1 = act4<2>(v1); }
                    u32x4 w; w.x = cvt_pk_bf16(v0[0], v0[1]); w.y = cvt_pk_bf16(v0[2], v0[3]); w.z = cvt_pk_bf16(v1[0], v1[1]); w.w = cvt_pk_bf16(v1[2], v1[3]);
                    if (MODE == 1) *(u32x4*)(rowp + bj * HALF) = w; else keep = keep ^ w; } }
        if (MODE == 2) *(u32x4*)(O + (size_t)row0 * ldc + col0) = keep;
    }
};

struct EpiMl {
    static constexpr bool PERM = true, AFTER_DRAIN = false;
    bf16_t* P; float* G; const float* bgate;
    __device__ __forceinline__ void operator()(const f32x4 (&acc)[2][2][4][2], const Unit& u, int wr, int wc, int fr, int fq) const {
        const int row0 = u.pm * BM + wr * 64 + fr;
        if (u.pn < 12) {
            const float sc = (u.pn == 2 || u.pn == 3) ? 0.125f : 1.0f;
            const int col0 = u.pn * BM + wc * 32 + 8 * fq;
#pragma unroll
            for (int ai = 0; ai < 2; ++ai)
#pragma unroll
                for (int m = 0; m < 4; ++m) { bf16_t* rowp = P + (size_t)(row0 + ai * HALF + m * 16) * 3072 + col0;
#pragma unroll
                    for (int bj = 0; bj < 2; ++bj) { const f32x4 v0 = acc[ai][bj][m][0] * sc, v1 = acc[ai][bj][m][1] * sc;
                        u32x4 w; w.x = cvt_pk_bf16(v0[0], v0[1]); w.y = cvt_pk_bf16(v0[2], v0[3]); w.z = cvt_pk_bf16(v1[0], v1[1]); w.w = cvt_pk_bf16(v1[2], v1[3]);
                        *(u32x4*)(rowp + bj * HALF) = w; } }
        } else if (wc == 0) {
            const int col0 = 8 * fq;
            const f32x4 b0 = *(const f32x4*)(bgate + col0), b1 = *(const f32x4*)(bgate + col0 + 4);
#pragma unroll
            for (int ai = 0; ai < 2; ++ai)
#pragma unroll
                for (int m = 0; m < 4; ++m) { float* rowp = G + (size_t)(row0 + ai * HALF + m * 16) * 32 + col0;
                    *(f32x4*)(rowp) = acc[ai][0][m][0] + b0; *(f32x4*)(rowp + 4) = acc[ai][0][m][1] + b1; }
        }
    }
};

template <int CTRL> __device__ __forceinline__ float epi_dpp(float x) { return __builtin_bit_cast(float, __builtin_amdgcn_mov_dpp(__builtin_bit_cast(int, x), CTRL, 0xf, 0xf, true)); }
__device__ __forceinline__ float epi_row16_sum(float x) { x += epi_dpp<0xB1>(x); x += epi_dpp<0x4E>(x); x += epi_dpp<0x124>(x); x += epi_dpp<0x128>(x); return x; }
template <int ACT, int MODE, bool STATS> struct EpiSwap {
    static constexpr bool PERM = true, AFTER_DRAIN = false;
    bf16_t* VT; const float* bias; float* ST;
    __device__ __forceinline__ void operator()(const f32x4 (&acc)[2][2][4][2], const Unit& u, int wr, int wc, int fr, int fq) const {
        const int ch0 = u.pm * BM + wr * 64 + fr, tok0 = u.pn * BM + wc * 32 + 8 * fq;
        float bsv[2][4];
#pragma unroll
        for (int ai = 0; ai < 2; ++ai)
#pragma unroll
            for (int m = 0; m < 4; ++m) bsv[ai][m] = bias[ch0 + ai * HALF + m * 16];
#pragma unroll
        for (int bj = 0; bj < 2; ++bj) { const int tok = tok0 + bj * HALF;
            f32x4 s1a = {0.f, 0.f, 0.f, 0.f}, s1b = s1a, s2a = s1a, s2b = s1a;
            size_t tbase;
            if (MODE == 0) tbase = (size_t)(tok >> 7) * (3072 * 128) + (tok & 127);
            else { if (tok < 65536) { const int b_ = tok >> 13, t = tok & 8191; tbase = ((size_t)(b_ * 16) * 128 + (t >> 6)) * 4096 + (t & 63); }
                   else { const int l = tok - 65536; tbase = (size_t)67108864 + (size_t)((l >> 8) * 16) * 16384 + (l & 255); } }
#pragma unroll
            for (int ai = 0; ai < 2; ++ai)
#pragma unroll
                for (int m = 0; m < 4; ++m) { const int ch = ch0 + ai * HALF + m * 16; const float b = bsv[ai][m];
                    const f32x4 v0 = act4<ACT>(acc[ai][bj][m][0] + b), v1 = act4<ACT>(acc[ai][bj][m][1] + b);
                    if (STATS) { s1a += v0; s2a += v0 * v0; s1b += v1; s2b += v1 * v1; }
                    u32x4 w; w.x = cvt_pk_bf16(v0[0], v0[1]); w.y = cvt_pk_bf16(v0[2], v0[3]); w.z = cvt_pk_bf16(v1[0], v1[1]); w.w = cvt_pk_bf16(v1[2], v1[3]);
                    size_t off;
                    if (MODE == 0) off = tbase + (size_t)ch * 128;
                    else { const int head = ch >> 6, d = ch & 63; off = tbase + ((tok < 65536) ? ((size_t)head * 128 * 4096 + (size_t)d * 64) : ((size_t)head * 16384 + (size_t)d * 256)); }
                    *(u32x4*)(VT + off) = w; }
            if (STATS) {
#pragma unroll
                for (int e = 0; e < 4; ++e) { float a0 = s1a[e], q0 = s2a[e], a1 = s1b[e], q1 = s2b[e];
                    a0 = epi_row16_sum(a0); q0 = epi_row16_sum(q0); a1 = epi_row16_sum(a1); q1 = epi_row16_sum(q1);
                    if (fr == 0) { typedef float f32x2v __attribute__((ext_vector_type(2)));
                        *(f32x2v*)(ST + ((size_t)(tok + e) * 24 + u.pm * 2 + wr) * 2) = (f32x2v){a0, q0};
                        *(f32x2v*)(ST + ((size_t)(tok + 4 + e) * 24 + u.pm * 2 + wr) * 2) = (f32x2v){a1, q1}; } }
            }
        }
    }
};
template <class Epi, class Sched, bool ALIGN_EPI = false, bool SP2 = false>
__device__ __forceinline__ void gemm_phase(PG8_LAS unsigned char* lds, const Gemm g, const Sched& S, const Epi& E, int stag_ticks = 0) {
    if (stag_ticks > 0) { const unsigned long long t0_ = __builtin_amdgcn_s_memrealtime(); const unsigned long long dl_ = (unsigned long long)(((blockIdx.x >> 3) & 7u) * (unsigned)stag_ticks);
        while (__builtin_amdgcn_s_memrealtime() - t0_ < dl_) __builtin_amdgcn_s_sleep(8); }
    int tid_ = threadIdx.x; asm volatile("" : "+v"(tid_));
    const int tid = tid_, wid = __builtin_amdgcn_readfirstlane(tid >> 6), lane = tid & 63, wr = wid >> 2, wc = wid & 3, fr = lane & 15, fq = lane >> 4;
    const int K = g.K, nt = g.Kloop / BK;
    unsigned voffA[2], voffB[2];
#pragma unroll
    for (int i = 0; i < 2; ++i) { int R, C; stage_rc(tid * 16 + i * 8192, R, C); const int Rb = Epi::PERM ? ((R & ~31) + perm32(R & 31)) : R;
        voffA[i] = (unsigned)(R * K + C) * 2u; voffB[i] = (unsigned)(Rb * K + C) * 2u; }
    const size_t kstep = (size_t)(BK * 2);
    const size_t hstep = (size_t)HALF * K * 2;
    const size_t tstep = 2 * hstep;
    const unsigned ldsw = (unsigned)wid * 1024u;
    const int aoff = lds_byte(wr * 64 + fr, fq * 8), boff = lds_byte(wc * 32 + fr, fq * 8);
#define PG8_SA(b, h) (((b) * 2 + (h)) * HTB)
#define PG8_SB(b, h) ((4 + (b) * 2 + (h)) * HTB)
#define PG8_STAGE(bufoff, gbase, voff) do { _Pragma("unroll") for (int _i = 0; _i < 2; ++_i) \
        __builtin_amdgcn_global_load_lds((const unsigned*)((const char*)(gbase) + (voff)[_i]), (PG8_LAS unsigned*)(lds + (bufoff) + ldsw + _i * 8192), 16, 0, 0); } while (0)
#define PG8_LDA(dst, b, h) do { _Pragma("unroll") for (int m = 0; m < 4; ++m) _Pragma("unroll") for (int k = 0; k < 2; ++k) dst[m][k] = *(const PG8_LAS bf16x8*)(lds + PG8_SA(b, h) + aoff + m * 2048 + k * 1024); } while (0)
#define PG8_LDB(dst, b, h) do { _Pragma("unroll") for (int n = 0; n < 2; ++n) _Pragma("unroll") for (int k = 0; k < 2; ++k) dst[n][k] = *(const PG8_LAS bf16x8*)(lds + PG8_SB(b, h) + boff + n * 2048 + k * 1024); } while (0)
#define PG8_MMA(ai, bj, At, Bt) do { __builtin_amdgcn_s_setprio(1); _Pragma("unroll") for (int m = 0; m < 4; ++m) _Pragma("unroll") for (int n = 0; n < 2; ++n) _Pragma("unroll") for (int k = 0; k < 2; ++k) \
        acc[ai][bj][m][n] = __builtin_amdgcn_mfma_f32_16x16x32_bf16(Bt[n][k], At[m][k], acc[ai][bj][m][n], 0, 0, 0); __builtin_amdgcn_s_setprio(0); } while (0)
#define PG8_WAIT_V(n) asm volatile("s_waitcnt vmcnt(" #n ")" ::: "memory")
#define PG8_WAIT_L(n) asm volatile("s_waitcnt lgkmcnt(" #n ")" ::: "memory")
#define PG8_BAR __builtin_amdgcn_s_barrier()
#define PG8_SCHED __builtin_amdgcn_sched_barrier(0)
    Unit cur, nxt; int ui = 0;
    if (!S.next(0, cur)) return;
    f32x4 acc[2][2][4][2];
#pragma unroll
    for (int a = 0; a < 2; ++a)
#pragma unroll
        for (int b = 0; b < 2; ++b)
#pragma unroll
            for (int m = 0; m < 4; ++m)
#pragma unroll
                for (int n = 0; n < 2; ++n) acc[a][b][m][n] = (f32x4){0.f, 0.f, 0.f, 0.f};
    bf16x8 At[4][2], B0[2][2], B1[2][2];
    const char* cA = (const char*)g.A + (size_t)cur.pm * tstep + (size_t)cur.pk * g.kslice_bytes; const char* cB = (const char*)g.Bt + (size_t)cur.pn * tstep + (size_t)cur.pk * g.kslice_bytes;
    S.a_ready(cur);
    if constexpr (SP2) {
        PG8_STAGE(PG8_SB(0, 0), cB, voffB); PG8_STAGE(PG8_SB(0, 1), cB + hstep, voffB); PG8_STAGE(PG8_SA(0, 0), cA, voffA); PG8_STAGE(PG8_SA(0, 1), cA + hstep, voffA);
        if (wr == 1) PG8_BAR;
        PG8_WAIT_V(2); PG8_BAR;
        PG8_STAGE(PG8_SB(1, 0), cB + kstep, voffB); PG8_STAGE(PG8_SA(1, 0), cA + kstep, voffA); PG8_STAGE(PG8_SB(1, 1), cB + hstep + kstep, voffB);
        PG8_WAIT_V(6); PG8_BAR;
    } else {
        PG8_STAGE(PG8_SB(0, 0), cB, voffB); PG8_STAGE(PG8_SA(0, 0), cA, voffA); PG8_STAGE(PG8_SB(0, 1), cB + hstep, voffB); PG8_STAGE(PG8_SA(0, 1), cA + hstep, voffA);
        if (wr == 1) PG8_BAR;
        PG8_WAIT_V(4); PG8_BAR;
        PG8_STAGE(PG8_SB(1, 0), cB + kstep, voffB); PG8_STAGE(PG8_SA(1, 0), cA + kstep, voffA); PG8_STAGE(PG8_SB(1, 1), cB + hstep + kstep, voffB);
        PG8_WAIT_V(6); PG8_BAR;
    }
    for (;;) {
        const bool has_next = S.next(ui + 1, nxt);
        const char* nA = has_next ? (const char*)g.A + (size_t)nxt.pm * tstep + (size_t)nxt.pk * g.kslice_bytes : cA; const char* nB = has_next ? (const char*)g.Bt + (size_t)nxt.pn * tstep + (size_t)nxt.pk * g.kslice_bytes : cB;
        for (int t = 0; t < nt; t += 2) {
            const bool last = (t == nt - 2);
            const char* a1 = cA + (size_t)(t + 1) * kstep;
            const char* a2 = last ? nA : cA + (size_t)(t + 2) * kstep; const char* b2 = last ? nB : cB + (size_t)(t + 2) * kstep;
            const char* a3 = a2 + kstep; const char* b3 = b2 + kstep;
            if (last && has_next) S.a_ready(nxt);
            if constexpr (SP2) {
            PG8_LDB(B0, 0, 0); PG8_LDB(B1, 0, 1); PG8_SCHED; PG8_LDA(At, 0, 0); PG8_STAGE(PG8_SA(1, 1), a1 + hstep, voffA);
            PG8_WAIT_V(8); PG8_WAIT_L(0); PG8_BAR; PG8_MMA(0, 0, At, B0); PG8_MMA(0, 1, At, B1); PG8_BAR; PG8_SCHED;
            PG8_LDA(At, 0, 1); PG8_STAGE(PG8_SB(0, 0), b2, voffB); PG8_STAGE(PG8_SB(0, 1), b2 + hstep, voffB); PG8_STAGE(PG8_SA(0, 0), a2, voffA);
            PG8_WAIT_V(8); PG8_WAIT_L(0); PG8_BAR; PG8_MMA(1, 0, At, B0); PG8_MMA(1, 1, At, B1); PG8_BAR; PG8_SCHED;
            PG8_LDB(B0, 1, 0); PG8_LDB(B1, 1, 1); PG8_SCHED; PG8_LDA(At, 1, 0); PG8_STAGE(PG8_SA(0, 1), a2 + hstep, voffA);
            PG8_WAIT_V(8); PG8_WAIT_L(0); PG8_BAR; PG8_MMA(0, 0, At, B0); PG8_MMA(0, 1, At, B1); PG8_BAR; PG8_SCHED;
            PG8_LDA(At, 1, 1); PG8_STAGE(PG8_SB(1, 0), b3, voffB); PG8_STAGE(PG8_SB(1, 1), b3 + hstep, voffB); PG8_STAGE(PG8_SA(1, 0), a3, voffA);
            PG8_WAIT_V(8); PG8_WAIT_L(0); PG8_BAR; PG8_MMA(1, 0, At, B0); PG8_MMA(1, 1, At, B1); PG8_BAR; PG8_SCHED;
            } else {
            PG8_LDB(B0, 0, 0); PG8_SCHED; PG8_LDA(At, 0, 0); PG8_STAGE(PG8_SA(1, 1), a1 + hstep, voffA);
            PG8_WAIT_L(8); PG8_BAR; PG8_WAIT_L(0); PG8_MMA(0, 0, At, B0); PG8_BAR; PG8_SCHED;
            PG8_LDB(B1, 0, 1); PG8_STAGE(PG8_SB(0, 0), b2, voffB);
            PG8_BAR; PG8_WAIT_L(0); PG8_MMA(0, 1, At, B1); PG8_BAR;
            PG8_LDA(At, 0, 1); PG8_STAGE(PG8_SA(0, 0), a2, voffA);
            PG8_BAR; PG8_WAIT_L(0); PG8_MMA(1, 0, At, B0); PG8_BAR; PG8_SCHED;
            PG8_STAGE(PG8_SB(0, 1), b2 + hstep, voffB);
            PG8_WAIT_V(6); PG8_BAR; PG8_MMA(1, 1, At, B1); PG8_BAR;
            PG8_LDB(B0, 1, 0); PG8_SCHED; PG8_LDA(At, 1, 0); PG8_STAGE(PG8_SA(0, 1), a2 + hstep, voffA);
            PG8_WAIT_L(8); PG8_BAR; PG8_WAIT_L(0); PG8_MMA(0, 0, At, B0); PG8_BAR; PG8_SCHED;
            PG8_LDB(B1, 1, 1); PG8_STAGE(PG8_SB(1, 0), b3, voffB);
            PG8_BAR; PG8_WAIT_L(0); PG8_MMA(0, 1, At, B1); PG8_BAR;
            PG8_LDA(At, 1, 1); PG8_STAGE(PG8_SA(1, 0), a3, voffA);
            PG8_BAR; PG8_WAIT_L(0); PG8_MMA(1, 0, At, B0); PG8_BAR; PG8_SCHED;
            PG8_STAGE(PG8_SB(1, 1), b3 + hstep, voffB);
            PG8_WAIT_V(6); PG8_BAR; PG8_MMA(1, 1, At, B1); PG8_BAR;
            }
        }
        if constexpr (ALIGN_EPI) { if (wr == 0) PG8_BAR; }
        if constexpr (!Epi::AFTER_DRAIN) { E(acc, cur, wr, wc, fr, fq); S.done(cur); }
        if (!has_next) break;
#pragma unroll
        for (int a = 0; a < 2; ++a)
#pragma unroll
            for (int b = 0; b < 2; ++b)
#pragma unroll
                for (int m = 0; m < 4; ++m)
#pragma unroll
                    for (int n = 0; n < 2; ++n) acc[a][b][m][n] = (f32x4){0.f, 0.f, 0.f, 0.f};
        cur = nxt; cA = nA; cB = nB; ++ui;
        if constexpr (ALIGN_EPI) { if (wr == 1) PG8_BAR; }
    }
    PG8_WAIT_V(0);
    if constexpr (!ALIGN_EPI) { if (wr == 0) PG8_BAR; }
    PG8_BAR;
    if constexpr (Epi::AFTER_DRAIN) { E.fused(acc, cur, wr, wc, fr, fq, lds, wid, lane); S.done(cur); }
#undef PG8_SA
#undef PG8_SB
#undef PG8_STAGE
#undef PG8_LDA
#undef PG8_LDB
#undef PG8_MMA
#undef PG8_WAIT_V
#undef PG8_WAIT_L
#undef PG8_BAR
#undef PG8_SCHED
}
}

constexpr int D = 1024, NBATCH = 8, SEQ = 8192, CTXL = 256, DEPTH = 4, FF = 4096, GH = 3072;
constexpr int TLAT = NBATCH * SEQ, TCTX = NBATCH * CTXL, TT = TLAT + TCTX;
constexpr float NORM_EPS = 1e-6f;
constexpr int NWAVES = 8, NTHREADS = 512;

constexpr size_t MiB = 1u << 20;
constexpr size_t WS_CTL = 0, CTL_ZERO_BYTES = 64 * 1024;
constexpr size_t WS_MODS = 1 * MiB;
constexpr size_t WS_ROPE = 2 * MiB;
constexpr size_t WS_XC = 3 * MiB;
constexpr size_t WS_WA = 11 * MiB, WS_WB = 45 * MiB;
constexpr size_t WS_STATS = 79 * MiB;
constexpr size_t WS_HBUF = 92 * MiB;
constexpr size_t WS_BIG = 224 * MiB;
constexpr size_t WS_Y = 752 * MiB;
constexpr size_t WS_NEED = 1016 * MiB;
constexpr size_t WS_GM_U = WS_BIG, WS_GM_VT = WS_BIG + 396 * MiB;
constexpr size_t WS_HID = WS_BIG;
constexpr size_t WS_NA_Q = WS_BIG, WS_NA_K = WS_BIG + 132 * MiB, WS_NA_VT = WS_BIG + 264 * MiB, WS_NA_O = WS_BIG + 396 * MiB;
constexpr size_t WS_ML_P = WS_BIG, WS_ML_G = WS_BIG + 396 * MiB, WS_ML_HD = WS_BIG + 405 * MiB;
static_assert(WS_GM_VT + 396 * MiB <= 1016 * MiB && WS_ML_HD + 264 * MiB <= 1016 * MiB && WS_HID + 528 * MiB <= WS_Y, "ws map");
constexpr size_t WO_GM_IN = 0, WO_GM_OUT = (size_t)6144 * 1024, WO_GM_W1 = WO_GM_OUT + (size_t)1024 * 3072, WO_GM_W2 = WO_GM_W1 + (size_t)4096 * 1024;
constexpr size_t WO_NA_QKV = 0, WO_NA_O = (size_t)3072 * 1024, WO_NA_W1 = WO_NA_O + (size_t)1024 * 1024, WO_NA_W2 = WO_NA_W1 + (size_t)4096 * 1024;
constexpr size_t WO_ML_IN = 0, WO_ML_OUT = (size_t)3328 * 1024, WO_ML_W1 = WO_ML_OUT + (size_t)1024 * 1024, WO_ML_W2 = WO_ML_W1 + (size_t)4096 * 1024;
static_assert((WO_GM_W2 + (size_t)4096 * 1024) * 2 <= 34 * MiB, "weight region");
constexpr int CW_BAR = 1024;

constexpr int RING_OFF = 0, RING_BYTES = 131072;
constexpr int LDS_BYTES = 147456;
constexpr int LDSCTL_OFF = LDS_BYTES - 512, MISC_OFF = LDSCTL_OFF + 320;

#define GAS __attribute__((address_space(1)))
#define LAS __attribute__((address_space(3)))
typedef unsigned short bf16;
typedef unsigned v4u __attribute__((ext_vector_type(4)));
typedef unsigned v2u __attribute__((ext_vector_type(2)));
typedef float f32x4 __attribute__((ext_vector_type(4)));
typedef float f32x2 __attribute__((ext_vector_type(2)));
typedef short bf16x8 __attribute__((ext_vector_type(8)));
#define LDS_WAIT() asm volatile("s_waitcnt lgkmcnt(0)" ::: "memory")
#define VM_WAIT() asm volatile("s_waitcnt vmcnt(0)" ::: "memory")
#define LDS_BARRIER() do { asm volatile("s_waitcnt lgkmcnt(0)" ::: "memory"); __builtin_amdgcn_s_barrier(); asm volatile("" ::: "memory"); } while (0)
__device__ __forceinline__ unsigned f2bf(float f) { unsigned u = __builtin_bit_cast(unsigned, f); return (u + 0x7fffu + ((u >> 16) & 1u)) >> 16; }
typedef __bf16 bf16v2 __attribute__((ext_vector_type(2)));
__device__ __forceinline__ unsigned pk2(float lo, float hi) { const f32x2 v = {lo, hi}; const bf16v2 b = __builtin_convertvector(v, bf16v2); return __builtin_bit_cast(unsigned, b); }
__device__ __forceinline__ float bflo(unsigned w) { return __builtin_bit_cast(float, w << 16); }
__device__ __forceinline__ float bfhi(unsigned w) { return __builtin_bit_cast(float, w & 0xffff0000u); }
__device__ __forceinline__ float fexp(float x) { return __builtin_amdgcn_exp2f(x * 1.4426950408889634f); }
#define MFMA16(a, b, c) __builtin_amdgcn_mfma_f32_16x16x32_bf16((a), (b), (c), 0, 0, 0)

template <int CTRL> __device__ __forceinline__ float dppf(float x) { return __builtin_bit_cast(float, __builtin_amdgcn_mov_dpp(__builtin_bit_cast(int, x), CTRL, 0xf, 0xf, true)); }
constexpr int DPP_XOR1 = 0xB1, DPP_XOR2 = 0x4E, DPP_HMIRROR = 0x141, DPP_ROR4 = 0x124, DPP_ROR8 = 0x128;
__device__ __forceinline__ float row16_sum(float x) { x += dppf<DPP_XOR1>(x); x += dppf<DPP_XOR2>(x); x += dppf<DPP_ROR4>(x); x += dppf<DPP_ROR8>(x); return x; }
__device__ __forceinline__ float xrow_sum(float x) {
    auto s = __builtin_amdgcn_permlane16_swap(__float_as_uint(x), __float_as_uint(x), false, false);
    x = __uint_as_float(s[0]) + __uint_as_float(s[1]);
    auto t = __builtin_amdgcn_permlane32_swap(__float_as_uint(x), __float_as_uint(x), false, false);
    return __uint_as_float(t[0]) + __uint_as_float(t[1]); }
__device__ __forceinline__ float xrow_max(float x) {
    auto s = __builtin_amdgcn_permlane16_swap(__float_as_uint(x), __float_as_uint(x), false, false);
    x = fmaxf(__uint_as_float(s[0]), __uint_as_float(s[1]));
    auto t = __builtin_amdgcn_permlane32_swap(__float_as_uint(x), __float_as_uint(x), false, false);
    return fmaxf(__uint_as_float(t[0]), __uint_as_float(t[1])); }
#define XB_TMO      128
#define XB_XCNT(j)  (256  + 64 * (j))
#define XB_XSUB(j)  (1280 + 64 * (j))
#define XB_XGEN(j)  (2304 + 64 * (j))
#define XB_TOP      3328
#define XB_TOPGEN   3392
#define XCD_BAR_WORDS 3456
#define XB_SPIN_CAP (1u << 18)

__device__ __forceinline__ unsigned xb_ld(unsigned* p)              { return __hip_atomic_load(p, __ATOMIC_RELAXED, __HIP_MEMORY_SCOPE_AGENT); }
__device__ __forceinline__ unsigned xb_add(unsigned* p, unsigned v) { return __hip_atomic_fetch_add(p, v, __ATOMIC_RELAXED, __HIP_MEMORY_SCOPE_AGENT); }
__device__ __forceinline__ unsigned xb_xcc_id() { return (unsigned)__builtin_amdgcn_s_getreg((3 << 11) | 20) & 0xFu; }
#define XB_SPIN(cond, bar) do { unsigned _sp = 0; while (cond) { __builtin_amdgcn_s_sleep(1); \
    if ((++_sp & 255u) == 0u) { if (xb_ld(&(bar)[XB_TMO])) break; if (_sp > XB_SPIN_CAP) { atomicAdd(&(bar)[XB_TMO], 1u); break; } } } } while (0)

struct XcdBarrier {
    unsigned* bar; unsigned x;
    volatile LAS unsigned* st;
};

__device__ __forceinline__ XcdBarrier xcd_barrier_post(unsigned* bar, volatile LAS unsigned* st) {
    XcdBarrier b; b.bar = bar; b.x = xb_xcc_id(); b.st = st;
    if (threadIdx.x == 0) (void)xb_add(&bar[XB_XCNT(b.x)], 1u);
    return b;
}
__device__ __forceinline__ void xcd_barrier_complete(unsigned* bar, unsigned x, unsigned& nloc, unsigned& nx) {
    const unsigned G = gridDim.x * gridDim.y * gridDim.z;
    unsigned sum, cnt, mine, sp = 0u;
    for (;;) {
        sum = 0u; cnt = 0u; mine = 0u;
#pragma unroll
        for (unsigned j = 0; j < 16; ++j) { const unsigned c = xb_ld(&bar[XB_XCNT(j)]); sum += c; cnt += (c > 0u) ? 1u : 0u; mine = (j == x) ? c : mine; }
        if (sum == G) break;
        __builtin_amdgcn_s_sleep(1);
        if ((++sp & 255u) == 0u) { if (xb_ld(&bar[XB_TMO])) break; if (sp > XB_SPIN_CAP) { atomicAdd(&bar[XB_TMO], 1u); break; } }
    }
    nloc = mine > 0u ? mine : 1u; nx = cnt > 0u ? cnt : 1u;
}

__device__ __forceinline__ void xcd_barrier(const XcdBarrier& b) {
    asm volatile("s_waitcnt vmcnt(0)" ::: "memory");
    __syncthreads();
    if (threadIdx.x == 0) {
        unsigned* bar = b.bar;
        __builtin_amdgcn_s_waitcnt(0);
        unsigned nloc = b.st[0], nx = b.st[1];
        if (nloc == 0u) { xcd_barrier_complete(bar, b.x, nloc, nx); b.st[0] = nloc; b.st[1] = nx; }
        const unsigned old = xb_add(&bar[XB_XSUB(b.x)], 1u);
        const unsigned gen = old / nloc;
        if (old + 1u == (gen + 1u) * nloc) {
            __builtin_amdgcn_fence(__ATOMIC_RELEASE, "agent");
            asm volatile("s_waitcnt vmcnt(0)" ::: "memory");
            const unsigned og = xb_add(&bar[XB_TOP], 1u);
            const unsigned tg = og / nx;
            if (og + 1u == (tg + 1u) * nx) xb_add(&bar[XB_TOPGEN], 1u);
            else XB_SPIN(xb_ld(&bar[XB_TOPGEN]) == tg, bar);
            __builtin_amdgcn_fence(__ATOMIC_ACQUIRE, "agent");
            xb_add(&bar[XB_XGEN(b.x)], 1u);
            asm volatile("s_waitcnt vmcnt(0)" ::: "memory");
        } else {
            XB_SPIN(xb_ld(&bar[XB_XGEN(b.x)]) == gen, bar);
            __builtin_amdgcn_fence(__ATOMIC_ACQUIRE, "agent");
            asm volatile("s_waitcnt vmcnt(0)" ::: "memory");
        }
    }
    __syncthreads();
}

struct Frame {
    LAS unsigned char* lds;
    int tid, lane, wave, G, gw, NGW;
    const float* in[25];
    float* out; unsigned char* ws;
};
__device__ __forceinline__ float wave_sum(float v) { return xrow_sum(row16_sum(v)); }
__device__ __forceinline__ void transpose_item(const float* W, int K, int N, bf16* WT, LAS float* scr, int item, int lane) {
    const int nblk = N / 32, kb = item / nblk, nb = item % nblk, k0 = 64 * kb, n0 = 32 * nb;
#pragma unroll 8
    for (int i = 0; i < 32; ++i) { const int kk = 2 * i + (lane >> 5); scr[kk * 33 + (lane & 31)] = W[(size_t)(k0 + kk) * N + n0 + (lane & 31)]; }
    LDS_WAIT(); asm volatile("" ::: "memory");
    const int c = lane & 7;
#pragma unroll
    for (int j = 0; j < 4; ++j) { const int n = (lane >> 3) + 8 * j; const LAS float* s = scr + (8 * c) * 33 + n;
        v4u o; o.x = pk2(s[0 * 33], s[1 * 33]); o.y = pk2(s[2 * 33], s[3 * 33]); o.z = pk2(s[4 * 33], s[5 * 33]); o.w = pk2(s[6 * 33], s[7 * 33]);
        *(v4u*)(WT + (size_t)(n0 + n) * K + k0 + 8 * c) = o; }
    LDS_WAIT(); asm volatile("" ::: "memory");
}
__device__ __forceinline__ void convert_layer(const Frame& F0, int layer, bf16* WR) {
    Frame F = F0; asm volatile("" : "+v"(F.tid)); F.lane = F.tid & 63;
    LAS float* scr = (LAS float*)(F.lds + RING_OFF + F.wave * 16384);
    const int kind = layer % 3, j = layer / 3;
    const float *W0, *W1; int N0, K1; size_t o1, o2, o3;
    if (kind == 0) { W0 = F.in[9] + (size_t)j * 1024 * 6144; N0 = 6144; W1 = F.in[14] + (size_t)j * 3072 * 1024; K1 = 3072; o1 = WO_GM_OUT; o2 = WO_GM_W1; o3 = WO_GM_W2; }
    else if (kind == 1) { W0 = F.in[15]; N0 = 3072; W1 = F.in[18]; K1 = 1024; o1 = WO_NA_O; o2 = WO_NA_W1; o3 = WO_NA_W2; }
    else { W0 = F.in[20]; N0 = 3072; W1 = F.in[24]; K1 = 1024; o1 = WO_ML_OUT; o2 = WO_ML_W1; o3 = WO_ML_W2; }
    const float* W2 = F.in[7] + (size_t)layer * 1024 * 4096; const float* W3 = F.in[8] + (size_t)layer * 4096 * 1024;
    const int I0 = 16 * (N0 / 32), I1 = (K1 / 64) * 32, I2 = 16 * 128, I3 = 64 * 32;
    for (int it = F.gw; it < I0 + I1 + I2 + I3; it += F.NGW) {
        int r = it;
        if (r < I0) { transpose_item(W0, 1024, N0, WR, scr, r, F.lane); continue; } r -= I0;
        if (r < I1) { transpose_item(W1, K1, 1024, WR + o1, scr, r, F.lane); continue; } r -= I1;
        if (r < I2) { transpose_item(W2, 1024, 4096, WR + o2, scr, r, F.lane); continue; } r -= I2;
        transpose_item(W3, 4096, 1024, WR + o3, scr, r, F.lane);
    }
    if (kind == 2) {
        const float* wg = F.in[21];
        bf16* ext = WR + (size_t)3072 * 1024;
        for (int i = F.gw * 64 + F.lane; i < 256 * 1024; i += F.NGW * 64) { const int rr = i >> 10, d = i & 1023;
            float v = 0.f; if (rr < 32) v = wg[((size_t)(rr >> 4) * 1024 + d) * 16 + (rr & 15)];
            ext[i] = (bf16)f2bf(v); }
    }
}
__device__ __forceinline__ void mods_phase(const Frame& F0) {
    Frame F = F0; asm volatile("" : "+v"(F.tid)); F.lane = F.tid & 63;
    LAS float* cact = (LAS float*)(F.lds);
    LAS float* red = (LAS float*)(F.lds + 9 * 4096);
    float* MODS = (float*)(F.ws + WS_MODS);
    const float* c = F.in[1]; const float* cc = F.in[3];
    for (int i = F.tid; i < 9 * 1024; i += NTHREADS) { const float v = i < 8192 ? c[i] : cc[i - 8192]; cact[i] = v / (1.0f + __expf(-v)); }
    __syncthreads();
    for (int item = blockIdx.x; item < DEPTH * 96; item += F.G) {
        const int layer = item / 96, cb = item % 96, col = cb * 64 + F.lane;
        const float* W = F.in[4] + (size_t)layer * 1024 * 6144 + col;
        float a[9];
#pragma unroll
        for (int m = 0; m < 9; ++m) a[m] = 0.f;
        const int k0 = F.wave * 128;
#pragma unroll 16
        for (int k = k0; k < k0 + 128; ++k) { const float w = W[(size_t)k * 6144];
#pragma unroll
            for (int m = 0; m < 9; ++m) a[m] += cact[m * 1024 + k] * w; }
#pragma unroll
        for (int m = 0; m < 9; ++m) red[(F.wave * 9 + m) * 64 + F.lane] = a[m];
        __syncthreads();
        for (int i = F.tid; i < 9 * 64; i += NTHREADS) { const int m = i >> 6, l = i & 63; float s = 0.f;
#pragma unroll
            for (int w = 0; w < 8; ++w) s += red[(w * 9 + m) * 64 + l];
            MODS[((size_t)layer * 9 + m) * 6144 + cb * 64 + l] = s + F.in[5][(size_t)layer * 6144 + cb * 64 + l]; }
        __syncthreads();
    }
    float* ROPE = (float*)(F.ws + WS_ROPE);
    for (int i = blockIdx.x * NTHREADS + F.tid; i < 2048; i += F.G * NTHREADS) { const int pos = i >> 4, fi = i & 15;
        const float inv = exp2f(-(float)fi * (13.287712379549449f / 16.0f)); const float ang = (float)pos * inv;
        ROPE[i] = cosf(ang); ROPE[2048 + i] = sinf(ang); }
}
template <bool HAS_Y, bool HAS_H, bool SRC16, bool DST16>
__device__ __forceinline__ void row_phase(const Frame& F0, int M, const float* src_lat, const float* src_ctx, const bf16* src16, float* dst_lat, bf16* dst16,
                                          const bf16* Y, const float* gy, const float* mod_gate  ,
                                          const float* gh, const float* mod_scale, const float* mod_shift, bf16* H, const float* PART = nullptr, int KP = 0, const float* pbias = nullptr) {
    Frame F = F0; asm volatile("" : "+v"(F.tid)); F.lane = F.tid & 63;
    const int nl = TLAT / F.NGW, nrow = nl + ((M > TLAT && F.gw < M - TLAT) ? 1 : 0);
    const int lat0 = F.gw * nl;
    const int cl = 4 * F.lane;
    int mb_c = -1; f32x4 va[4], vb[4], vc[4];
    f32x4 xn[4]; v2u xn16[4]; v2u yn[4];
    { const int r0 = lat0; const float* xs = src_lat + (size_t)r0 * D;
#pragma unroll
      for (int j = 0; j < 4; ++j) { if (SRC16) xn16[j] = *(const v2u*)(src16 + (size_t)r0 * D + cl + 256 * j); else xn[j] = *(const f32x4*)(xs + cl + 256 * j);
          if (HAS_Y) yn[j] = *(const v2u*)(Y + (size_t)r0 * D + cl + 256 * j); } }
    for (int i = 0; i < nrow; ++i) {
        const int r = i < nl ? lat0 + i : TLAT + F.gw;
        f32x4 x[4]; v2u yv[4];
#pragma unroll
        for (int j = 0; j < 4; ++j) { if (SRC16) x[j] = (f32x4){bflo(xn16[j].x), bfhi(xn16[j].x), bflo(xn16[j].y), bfhi(xn16[j].y)}; else x[j] = xn[j]; if (HAS_Y) yv[j] = yn[j]; }
        if (i + 1 < nrow) { const int rn = i + 1 < nl ? lat0 + i + 1 : TLAT + F.gw; const float* xs = rn < TLAT ? src_lat + (size_t)rn * D : src_ctx + (size_t)(rn - TLAT) * D;
#pragma unroll
            for (int j = 0; j < 4; ++j) { if (SRC16) xn16[j] = *(const v2u*)(src16 + (size_t)rn * D + cl + 256 * j); else xn[j] = *(const f32x4*)(xs + cl + 256 * j);
                if (HAS_Y) yn[j] = *(const v2u*)(Y + (size_t)rn * D + cl + 256 * j); } }
        const int mb = r < TLAT ? (r >> 13) : 8;
        if (mb != mb_c) { mb_c = mb;
#pragma unroll
            for (int j = 0; j < 4; ++j) { const int c = cl + 256 * j;
                if (HAS_Y) va[j] = *(const f32x4*)(gy + c) * *(const f32x4*)(mod_gate + (size_t)mb * 6144 + c);
                if (HAS_H) { vb[j] = *(const f32x4*)(gh + c) * (*(const f32x4*)(mod_scale + (size_t)mb * 6144 + c) + 1.0f); vc[j] = *(const f32x4*)(mod_shift + (size_t)mb * 6144 + c); } } }
        if (HAS_Y) {
            f32x4 y[4]; float ss = 0.f;
            if (r >= TLAT && KP > 0) {
#pragma unroll
                for (int j = 0; j < 4; ++j) { f32x4 pv[8];
#pragma unroll
                    for (int p = 0; p < 8; ++p) pv[p] = (p < KP) ? *(const f32x4*)(PART + ((size_t)p * TCTX + (r - TLAT)) * D + cl + 256 * j) : (f32x4){0.f, 0.f, 0.f, 0.f};
                    f32x4 a = ((pv[0] + pv[1]) + (pv[2] + pv[3])) + ((pv[4] + pv[5]) + (pv[6] + pv[7]));
                    if (pbias) a = a + *(const f32x4*)(pbias + cl + 256 * j);
                    y[j] = a; }
            } else {
#pragma unroll
                for (int j = 0; j < 4; ++j) y[j] = (f32x4){bflo(yv[j].x), bfhi(yv[j].x), bflo(yv[j].y), bfhi(yv[j].y)};
            }
#pragma unroll
            for (int j = 0; j < 4; ++j) ss += (y[j][0] * y[j][0] + y[j][1] * y[j][1]) + (y[j][2] * y[j][2] + y[j][3] * y[j][3]);
            const float rs = 1.0f / sqrtf(wave_sum(ss) * (1.0f / D) + NORM_EPS);
#pragma unroll
            for (int j = 0; j < 4; ++j) { x[j] = x[j] + va[j] * (y[j] * rs);
                if (DST16) { v2u w; w.x = pk2(x[j][0], x[j][1]); w.y = pk2(x[j][2], x[j][3]); *(v2u*)(dst16 + (size_t)r * D + cl + 256 * j) = w;
                    x[j] = (f32x4){bflo(w.x), bfhi(w.x), bflo(w.y), bfhi(w.y)}; }
                else *(f32x4*)(dst_lat + (size_t)r * D + cl + 256 * j) = x[j]; }
        }
        if (HAS_H) {
            float ss = 0.f;
#pragma unroll
            for (int j = 0; j < 4; ++j) ss += (x[j][0] * x[j][0] + x[j][1] * x[j][1]) + (x[j][2] * x[j][2] + x[j][3] * x[j][3]);
            const float rs = 1.0f / sqrtf(wave_sum(ss) * (1.0f / D) + NORM_EPS);
#pragma unroll
            for (int j = 0; j < 4; ++j) { const f32x4 h = x[j] * rs * vb[j] + vc[j]; v2u w; w.x = pk2(h[0], h[1]); w.y = pk2(h[2], h[3]); *(v2u*)(H + (size_t)r * D + cl + 256 * j) = w; }
        }
    }
}

__device__ __forceinline__ void mix_phase(const Frame& F0, bool dry, int nchunks, const bf16* VT, bf16* U, const float* ST, const float* Wsp, const float* bsp, const float* lng) {
    Frame F = F0; asm volatile("" : "+v"(F.tid)); F.lane = F.tid & 63;
    constexpr int WPS = 136, TS = 784;
    LAS bf16* Wp = (LAS bf16*)(F.lds);
    LAS unsigned char* TILE = F.lds + 128 * WPS * 2;
    LAS float* rq = (LAS float*)(TILE + 128 * TS);
    LAS float* mu = rq + 128; LAS float* mm = mu + 128; LAS float* bsv = mm + 128; LAS float* gam = bsv + 128;
    const int fr = F.lane & 15, fq = F.lane >> 4;
    v4u ut[12];
    const int nun = nchunks * 8, u_beg = (int)(((long)blockIdx.x * nun) / F.G), u_end = (int)(((long)(blockIdx.x + 1) * nun) / F.G);
    int chunk_c = -1;
    if (u_beg < u_end) { const int unit = u_beg; const bf16* ub = U + ((size_t)(unit >> 3) * 128 + (F.tid >> 3)) * GH + (unit & 7) * 384 + (F.tid & 7) * 8;
#pragma unroll
        for (int i2 = 0; i2 < 2; ++i2)
#pragma unroll
            for (int k = 0; k < 6; ++k) ut[i2 * 6 + k] = *(const v4u*)(ub + (size_t)i2 * 64 * GH + k * 64); }
    for (int unit = u_beg; unit < u_end; ++unit) {
        const int chunk = unit >> 3, g = unit & 7;
        bf16* ubase = U + ((size_t)chunk * 128 + (F.tid >> 3)) * GH + g * 384 + (F.tid & 7) * 8;
        const int c0 = F.wave * 48;
        if (F.tid < 128) { bsv[F.tid] = bsp[g * 128 + F.tid];
            if (chunk != chunk_c) { const int tok = chunk * 128 + F.tid; float s = 0.f, q = 0.f;
#pragma unroll
                for (int sl = 0; sl < 24; sl += 2) { const f32x4 p = *(const f32x4*)(ST + ((size_t)tok * 24 + sl) * 2); s += p[0] + p[2]; q += p[1] + p[3]; }
                const float mean = s * (1.0f / GH), var = fmaxf(q * (1.0f / GH) - mean * mean, 0.f);
                rq[F.tid] = 1.0f / sqrtf(var + NORM_EPS); mu[F.tid] = mean; }
        } else gam[F.tid - 128] = lng[g * 384 + F.tid - 128];
        chunk_c = chunk;
        LAS unsigned char* tbase = TILE + (F.tid >> 3) * TS + (F.tid & 7) * 16;
#pragma unroll
        for (int i2 = 0; i2 < 2; ++i2)
#pragma unroll
            for (int k = 0; k < 6; ++k) *(LAS v4u*)(tbase + i2 * 64 * TS + k * 128) = ut[i2 * 6 + k];
        asm volatile("" ::: "memory");
        bf16x8 vf[4][3];
        { const bf16* vbase = VT + ((size_t)chunk * 3072 + g * 384 + c0 + fr) * 128 + fq * 8;
#pragma unroll
          for (int ks = 0; ks < 4; ++ks)
#pragma unroll
              for (int ct = 0; ct < 3; ++ct) vf[ks][ct] = *(const bf16x8*)(vbase + (size_t)ct * 16 * 128 + ks * 32); }
        __syncthreads();
        asm volatile("" ::: "memory");
        { const int p = F.tid >> 2, qs = (F.tid & 3) * 32; const float* wrow = Wsp + ((size_t)g * 128 + p) * 128 + qs; float macc = 0.f;
#pragma unroll
          for (int i = 0; i < 4; ++i) { const f32x4 w0 = *(const f32x4*)(wrow + 8 * i), w1 = *(const f32x4*)(wrow + 8 * i + 4); unsigned pk[4];
#pragma unroll
              for (int e = 0; e < 4; ++e) { const int q0 = qs + 8 * i + 2 * e; const float a = (e < 2 ? w0[2 * e] : w1[2 * e - 4]) * rq[q0], b = (e < 2 ? w0[2 * e + 1] : w1[2 * e - 3]) * rq[q0 + 1];
                  const unsigned w = pk2(a, b); pk[e] = w; macc += bflo(w) * mu[q0] + bfhi(w) * mu[q0 + 1]; }
              *(LAS v4u*)(Wp + p * WPS + qs + 8 * i) = (v4u){pk[0], pk[1], pk[2], pk[3]}; }
          macc += dppf<DPP_XOR1>(macc); macc += dppf<DPP_XOR2>(macc);
          if ((F.tid & 3) == 0) mm[p] = macc; }
        __syncthreads();
#pragma unroll
        for (int ph = 0; ph < 2; ++ph) {
            f32x4 acc[3][4];
#pragma unroll
            for (int ct = 0; ct < 3; ++ct)
#pragma unroll
                for (int pt = 0; pt < 4; ++pt) acc[ct][pt] = (f32x4){0.f, 0.f, 0.f, 0.f};
#pragma unroll
            for (int ks = 0; ks < 4; ++ks) {
#pragma unroll
                for (int pt = 0; pt < 4; ++pt) { const bf16x8 wf = *(const LAS bf16x8*)(Wp + (16 * (4 * ph + pt) + fr) * WPS + ks * 32 + fq * 8);
#pragma unroll
                    for (int ct = 0; ct < 3; ++ct) acc[ct][pt] = MFMA16(vf[ks][ct], wf, acc[ct][pt]); }
            }
#pragma unroll
            for (int pt = 0; pt < 4; ++pt) { const int p = 16 * (4 * ph + pt) + fr; const float mp = mm[p], bp = bsv[p];
#pragma unroll
                for (int ct = 0; ct < 3; ++ct) { const int c = c0 + 16 * ct + 4 * fq; LAS v2u* up = (LAS v2u*)(TILE + p * TS + c * 2); const v2u uu = *up;
                    const float o0 = bflo(uu.x) * (gam[c] * (acc[ct][pt][0] - mp) + bp), o1 = bfhi(uu.x) * (gam[c + 1] * (acc[ct][pt][1] - mp) + bp);
                    const float o2 = bflo(uu.y) * (gam[c + 2] * (acc[ct][pt][2] - mp) + bp), o3 = bfhi(uu.y) * (gam[c + 3] * (acc[ct][pt][3] - mp) + bp);
                    v2u w; w.x = pk2(o0, o1); w.y = pk2(o2, o3); if (dry) w = uu; *up = w; } }
            asm volatile("" ::: "memory");
        }
        __syncthreads();
        asm volatile("" ::: "memory");
        if (unit + 1 < u_end) { const int un = unit + 1; const bf16* ub = U + ((size_t)(un >> 3) * 128 + (F.tid >> 3)) * GH + (un & 7) * 384 + (F.tid & 7) * 8;
#pragma unroll
            for (int i2 = 0; i2 < 2; ++i2)
#pragma unroll
                for (int k = 0; k < 6; ++k) ut[i2 * 6 + k] = *(const v4u*)(ub + (size_t)i2 * 64 * GH + k * 64); }
#pragma unroll
        for (int i2 = 0; i2 < 2; ++i2)
#pragma unroll
            for (int k = 0; k < 6; ++k) { const v4u v = *(const LAS v4u*)(tbase + i2 * 64 * TS + k * 128); *(v4u*)(ubase + (size_t)i2 * 64 * GH + k * 64) = v; }
        __syncthreads();
    }
}

__device__ __forceinline__ int na_f(int key) { return ((key >> 1) & 1) | ((key >> 2) & 6); }
__device__ __forceinline__ int na_rs(int r) { return min(max(r - 4, 0), 120); }
__device__ __forceinline__ void na_phase(const Frame& F0, const bf16* Q, const bf16* Kb, const bf16* VT, bf16* O, const float* rpb) {
    Frame F = F0; asm volatile("" : "+v"(F.tid)); F.lane = F.tid & 63;
    constexpr int KW = 0, CK = 73728, CV = 106496, RP = 139264;
    LAS unsigned char* L = F.lds;
    LAS float* rp = (LAS float*)(L + RP);
    const int fr = F.lane & 15, fq = F.lane >> 4;
    const bf16* VTC = VT + (size_t)67108864;
    const int skey = F.tid >> 3, sc = F.tid & 7;
    for (int sidx = blockIdx.x; sidx < 512; sidx += F.G) {
        const int s = sidx < 256 ? sidx : 767 - sidx;
        const int b = s >> 6, head = (s >> 2) & 15, sp = s & 3;
        __syncthreads();
#pragma unroll
        for (int i = 0; i < 4; ++i) { const int q = F.tid + 512 * i;
            { const int key = q >> 3, c = q & 7; const v4u v = *(const v4u*)(Kb + ((size_t)TLAT + b * CTXL + key) * D + head * 64 + c * 8);
              *(LAS v4u*)(L + CK + key * 128 + ((c ^ na_f(key)) << 4)) = v; }
            { const int d = q >> 5, c = q & 31; const v4u v = *(const v4u*)(VTC + ((size_t)(b * 16 + head) * 64 + d) * 256 + c * 8);
              *(LAS v4u*)(L + CV + d * 512 + ((c ^ (d & 15)) << 4)) = v; } }
        for (int i = F.tid; i < 15 * 64; i += NTHREADS) { const int dr = i >> 6, cc = i & 63; rp[i] = cc < 31 ? rpb[head * 465 + dr * 31 + cc] * 1.4426950408889634f : -1e30f; }
        const int r0 = 32 * sp;
        int loaded_hi = na_rs(r0 + 1) + 7;
        for (int rr = na_rs(r0); rr <= loaded_hi; ++rr) {
            const v4u v = *(const v4u*)(Kb + ((size_t)b * SEQ + rr * 64 + skey) * D + head * 64 + sc * 8);
            *(LAS v4u*)(L + KW + (rr % 9) * 8192 + skey * 128 + ((sc ^ na_f(skey)) << 4)) = v; }
        const int nsteps = (sp < 2) ? 17 : 16;
        bf16x8 qn[2];
        { const int qt0 = b * SEQ + (r0 + (F.wave >> 2)) * 64 + 16 * (F.wave & 3) + fr;
#pragma unroll
          for (int ks = 0; ks < 2; ++ks) qn[ks] = *(const bf16x8*)(Q + (size_t)qt0 * D + head * 64 + ks * 32 + fq * 8); }
        for (int step = 0; step < nsteps; ++step) {
            const bool lat = step < 16;
            const int rbase = r0 + 2 * step;
            __syncthreads();
            v4u pre0 = {0u, 0u, 0u, 0u}, pre1 = pre0; int next_hi = loaded_hi;
            if (step + 1 < 16) { next_hi = na_rs(rbase + 3) + 7;
                if (loaded_hi + 1 <= next_hi) pre0 = *(const v4u*)(Kb + ((size_t)b * SEQ + (loaded_hi + 1) * 64 + skey) * D + head * 64 + sc * 8);
                if (loaded_hi + 2 <= next_hi) pre1 = *(const v4u*)(Kb + ((size_t)b * SEQ + (loaded_hi + 2) * 64 + skey) * D + head * 64 + sc * 8); }
            int r = 0, j = 0, qtok;
            if (lat) { r = rbase + (F.wave >> 2); j = F.wave & 3; qtok = b * SEQ + r * 64 + 16 * j + fr; }
            else qtok = TLAT + b * CTXL + sp * 128 + F.wave * 16 + fr;
            bf16x8 qf[2];
#pragma unroll
            for (int ks = 0; ks < 2; ++ks) qf[ks] = qn[ks];
            if (step + 1 < nsteps) { const int qt2 = (step + 1 < 16) ? (b * SEQ + (rbase + 2 + (F.wave >> 2)) * 64 + 16 * (F.wave & 3) + fr) : (TLAT + b * CTXL + sp * 128 + F.wave * 16 + fr);
#pragma unroll
                for (int ks = 0; ks < 2; ++ks) qn[ks] = *(const bf16x8*)(Q + (size_t)qt2 * D + head * 64 + ks * 32 + fq * 8); }
            f32x4 oacc[4];
#pragma unroll
            for (int dt = 0; dt < 4; ++dt) oacc[dt] = (f32x4){0.f, 0.f, 0.f, 0.f};
            float m_run = -1e30f, l_run = 0.f;
            const int kcol = 8 * (fr >> 2) + (fr & 3);
            if (lat) {
                const int rs = na_rs(r);
                const int kc0 = (j == 0) ? 0 : (j == 1) ? 8 : (j == 2) ? 24 : 32;
                f32x4 sl[16];
#pragma unroll
                for (int i = 0; i < 8; ++i) { const int slot = (rs + i) % 9;
#pragma unroll
                    for (int tb = 0; tb < 2; ++tb) { const int key = kc0 + kcol + 4 * tb; f32x4 a = {0.f, 0.f, 0.f, 0.f};
#pragma unroll
                        for (int ks = 0; ks < 2; ++ks) { const bf16x8 kf = *(const LAS bf16x8*)(L + KW + slot * 8192 + key * 128 + (((ks * 4 + fq) ^ na_f(key)) << 4)); a = MFMA16(kf, qf[ks], a); }
                        sl[i * 2 + tb] = a; } }
                const int qc = 16 * j + fr, wsq = min(max(qc - 8, 0), 48);
                const LAS float* rpw = rp + (rs - r + 7) * 64;
#pragma unroll
                for (int tb = 0; tb < 2; ++tb)
#pragma unroll
                    for (int e = 0; e < 4; ++e) { const int kc = kc0 + 8 * fq + 4 * tb + e; const bool valid = (kc >= wsq) && (kc < wsq + 16); const int cidx = valid ? (min(max(kc - qc, -15), 15) + 15) : 32;
#pragma unroll
                        for (int i = 0; i < 8; ++i) sl[i * 2 + tb][e] += rpw[i * 64 + cidx]; }
                float mx = -1e30f;
#pragma unroll
                for (int t = 0; t < 16; ++t) mx = fmaxf(fmaxf(fmaxf(sl[t][0], sl[t][1]), fmaxf(sl[t][2], sl[t][3])), mx);
                mx = xrow_max(mx);
                float sum = 0.f;
#pragma unroll
                for (int t = 0; t < 16; ++t)
#pragma unroll
                    for (int e = 0; e < 4; ++e) { const float p = __builtin_amdgcn_exp2f(sl[t][e] - mx); sl[t][e] = p; sum += p; }
                m_run = mx; l_run = sum;
                const bf16* vb0 = VT + (((size_t)(b * 16 + head) * 128 + rs) * 64 + fr) * 64 + kc0 + 8 * fq;
#pragma unroll
                for (int hb = 0; hb < 4; ++hb) {
                    bf16x8 vfr[2][4];
#pragma unroll
                    for (int i = 0; i < 2; ++i)
#pragma unroll
                        for (int dt = 0; dt < 4; ++dt) vfr[i][dt] = *(const bf16x8*)(vb0 + (size_t)(2 * hb + i) * 4096 + dt * 16 * 64);
#pragma unroll
                    for (int i4 = 0; i4 < 2; ++i4) { const int i = 2 * hb + i4; v4u pw; pw.x = pk2(sl[2 * i][0], sl[2 * i][1]); pw.y = pk2(sl[2 * i][2], sl[2 * i][3]); pw.z = pk2(sl[2 * i + 1][0], sl[2 * i + 1][1]); pw.w = pk2(sl[2 * i + 1][2], sl[2 * i + 1][3]);
                        const bf16x8 pf = __builtin_bit_cast(bf16x8, pw);
#pragma unroll
                        for (int dt = 0; dt < 4; ++dt) oacc[dt] = MFMA16(vfr[i4][dt], pf, oacc[dt]); } }
            }
            {
                f32x4 sx[16];
#pragma unroll
                for (int s8 = 0; s8 < 8; ++s8)
#pragma unroll
                    for (int tb = 0; tb < 2; ++tb) { const int key = 32 * s8 + kcol + 4 * tb; f32x4 a = {0.f, 0.f, 0.f, 0.f};
#pragma unroll
                        for (int ks = 0; ks < 2; ++ks) { const bf16x8 kf = *(const LAS bf16x8*)(L + CK + key * 128 + (((ks * 4 + fq) ^ na_f(key)) << 4)); a = MFMA16(kf, qf[ks], a); }
                        sx[s8 * 2 + tb] = a; }
                float mx = -1e30f;
#pragma unroll
                for (int t = 0; t < 16; ++t) mx = fmaxf(fmaxf(fmaxf(sx[t][0], sx[t][1]), fmaxf(sx[t][2], sx[t][3])), mx);
                mx = xrow_max(mx);
                const float mnew = fmaxf(mx, m_run), alpha = __builtin_amdgcn_exp2f(m_run - mnew);
#pragma unroll
                for (int dt = 0; dt < 4; ++dt) oacc[dt] = oacc[dt] * alpha;
                float sum = l_run * alpha;
#pragma unroll
                for (int t = 0; t < 16; ++t)
#pragma unroll
                    for (int e = 0; e < 4; ++e) { const float p = __builtin_amdgcn_exp2f(sx[t][e] - mnew); sx[t][e] = p; sum += p; }
                l_run = sum;
#pragma unroll
                for (int s8 = 0; s8 < 8; ++s8) { v4u pw; pw.x = pk2(sx[2 * s8][0], sx[2 * s8][1]); pw.y = pk2(sx[2 * s8][2], sx[2 * s8][3]); pw.z = pk2(sx[2 * s8 + 1][0], sx[2 * s8 + 1][1]); pw.w = pk2(sx[2 * s8 + 1][2], sx[2 * s8 + 1][3]);
                    const bf16x8 pf = __builtin_bit_cast(bf16x8, pw);
#pragma unroll
                    for (int dt = 0; dt < 4; ++dt) { const int d = 16 * dt + fr; const bf16x8 vf = *(const LAS bf16x8*)(L + CV + d * 512 + (((4 * s8 + fq) ^ fr) << 4)); oacc[dt] = MFMA16(vf, pf, oacc[dt]); } }
            }
            l_run = xrow_sum(l_run);
            const float inv = 1.0f / l_run;
#pragma unroll
            for (int dt = 0; dt < 4; ++dt) { v2u w; w.x = pk2(oacc[dt][0] * inv, oacc[dt][1] * inv); w.y = pk2(oacc[dt][2] * inv, oacc[dt][3] * inv);
                *(v2u*)(O + (size_t)qtok * D + head * 64 + 16 * dt + 4 * fq) = w; }
            __syncthreads();
            if (loaded_hi + 1 <= next_hi) *(LAS v4u*)(L + KW + ((loaded_hi + 1) % 9) * 8192 + skey * 128 + ((sc ^ na_f(skey)) << 4)) = pre0;
            if (loaded_hi + 2 <= next_hi) *(LAS v4u*)(L + KW + ((loaded_hi + 2) % 9) * 8192 + skey * 128 + ((sc ^ na_f(skey)) << 4)) = pre1;
            loaded_hi = next_hi;
        }
    }
}

__device__ __forceinline__ size_t scan_tokbase2(int s, int b, int dir) { if (s < 2) return (size_t)TLAT + b * CTXL + (dir ? 1 - s : s) * 128; return (size_t)b * SEQ + (dir ? 63 - (s - 2) : s - 2) * 128; }
__device__ __forceinline__ size_t scan_tokbase(int s, int b, int dir) { if (s < 4) return (size_t)TLAT + b * CTXL + (dir ? 3 - s : s) * 64; return (size_t)b * SEQ + (dir ? 127 - (s - 4) : s - 4) * 64; }
#define ML_GATE_SCAN(G_U) do { LAS float* g_u_ = (G_U); LAS float* g_M_ = g_u_ + L; LAS float* g_in_ = g_M_ + L; LAS float* g_em_ = g_in_ + L; LAS float* g_w_ = g_em_ + L; LAS float* g_dec_ = g_w_ + L; \
                const float lf0 = fminf(rgf[0], 0.f) - log1pf(__expf(-fabsf(rgf[0]))), lf1 = fminf(rgf[1], 0.f) - log1pf(__expf(-fabsf(rgf[1]))); \
                float b0 = lf0, b1 = lf1; \
                _Pragma("unroll") for (int o = 1; o < 64; o <<= 1) { const float t0 = __shfl_up(b0, o), t1 = __shfl_up(b1, o); if (F.lane >= o) { b0 += t0; b1 += t1; } } \
                b1 += __shfl(b0, 63); \
                const float u0 = rgi[0] - b0, u1 = rgi[1] - b1; float c0 = u0, c1 = u1; \
                _Pragma("unroll") for (int o = 1; o < 64; o <<= 1) { const float t0 = __shfl_up(c0, o), t1 = __shfl_up(c1, o); if (F.lane >= o) { c0 = fmaxf(c0, t0); c1 = fmaxf(c1, t1); } } \
                c1 = fmaxf(c1, __shfl(c0, 63)); \
                const float M0 = fmaxf(m_st, c0), M1 = fmaxf(m_st, c1); \
                const float Ml = __shfl(M1, 63), bl = __shfl(b1, 63); \
                g_u_[F.lane] = u0; g_u_[F.lane + 64] = u1; g_M_[F.lane] = M0; g_M_[F.lane + 64] = M1; g_in_[F.lane] = fexp(m_st - M0); g_in_[F.lane + 64] = fexp(m_st - M1); \
                g_em_[F.lane] = fexp(-b0 - M0); g_em_[F.lane + 64] = fexp(-b1 - M1); g_w_[F.lane] = fexp(u0 - Ml); g_w_[F.lane + 64] = fexp(u1 - Ml); \
                if (F.lane == 0) g_dec_[0] = fexp(m_st - Ml); \
                m_st = bl + Ml; } while (0)
#define ML_GATE_LOAD(SIDX) do { const size_t tg_ = scan_tokbase2((SIDX), b, dir); _Pragma("unroll") for (int h2 = 0; h2 < 2; ++h2) { const size_t tk = tg_ + (dir ? 127 - (F.lane + 64 * h2) : F.lane + 64 * h2); rgi[h2] = Gt[tk * 32 + dir * 16 + head]; rgf[h2] = Gt[tk * 32 + dir * 16 + 8 + head]; } } while (0)
__device__ __forceinline__ void scan_phase(const Frame& F0, const bf16* P, const float* Gt, bf16* HD, const float* ROPE) {
    Frame F = F0; asm volatile("" : "+v"(F.tid)); F.lane = F.tid & 63;
    constexpr int LS = 72, LT = 136, L = 128, NSTEP = 66;
    LAS bf16* Qs = (LAS bf16*)(F.lds);
    LAS bf16* Ks = Qs + L * LS;
    LAS bf16* VTs = Ks + L * LS;
    LAS bf16* KwT = VTs + 80 * LT;
    LAS bf16* As = KwT + 64 * LT;
    LAS bf16* CT0 = As + L * LT;
    LAS bf16* CT1 = CT0 + 80 * LS;
    LAS float* gbase = (LAS float*)(CT1 + 80 * LS);
    constexpr int GSET = 5 * L + 4;
    const int fr = F.lane & 15, fq = F.lane >> 4;
    const int soff = F.tid >> 3, seg = F.tid & 7;
    for (int unit = blockIdx.x; unit < 256; unit += F.G) {
        const int b = unit >> 5, head = (unit >> 2) & 7, dir = (unit >> 1) & 1, vh = unit & 1;
        for (int i = F.tid; i < 80 * LT; i += NTHREADS) { if (i < 80 * LS) CT0[i] = 0; if (i >= 64 * LT) VTs[i] = (i < 65 * LT) ? (bf16)0x3F80u : (bf16)0; }
        f32x4 st[3];
#pragma unroll
        for (int x = 0; x < 3; ++x) st[x] = (f32x4){0.f, 0.f, 0.f, 0.f};
        float m_st = 0.f;
        v4u rq_[2], rk_[2], rv_[2]; float rgi[2] = {0.f, 0.f}, rgf[2] = {0.f, 0.f};
        { const size_t tb = scan_tokbase2(0, b, dir);
#pragma unroll
          for (int h2 = 0; h2 < 2; ++h2) { const bf16* pr = P + (tb + soff + 64 * h2) * 3072;
              rq_[h2] = *(const v4u*)(pr + head * 64 + seg * 8); rk_[h2] = *(const v4u*)(pr + 512 + head * 64 + seg * 8); rv_[h2] = *(const v4u*)(pr + 1024 + head * 128 + vh * 64 + seg * 8);
 } }
        if (F.wave == 0) { ML_GATE_LOAD(0); ML_GATE_SCAN(gbase); ML_GATE_LOAD(1); }
        __syncthreads();
        for (int s = 0; s < NSTEP; ++s) {
            LAS bf16* CTc = (s & 1) ? CT1 : CT0; LAS bf16* CTn = (s & 1) ? CT0 : CT1;
            const bool latent = s >= 2; const int cidx = latent ? (dir ? 63 - (s - 2) : s - 2) : 0;
            const size_t tb = scan_tokbase2(s, b, dir);
            LAS float* g_u = gbase + (s & 1) * GSET; LAS float* g_M = g_u + L; LAS float* g_in = g_M + L; LAS float* g_em = g_in + L; LAS float* g_w = g_em + L; LAS float* g_dec = g_w + L;
            float kv[2][8];
#pragma unroll
            for (int h2 = 0; h2 < 2; ++h2) { const int off = soff + 64 * h2, tau = dir ? 127 - off : off;
              float qv[8]; const unsigned qw[4] = {rq_[h2].x, rq_[h2].y, rq_[h2].z, rq_[h2].w}, kw[4] = {rk_[h2].x, rk_[h2].y, rk_[h2].z, rk_[h2].w};
#pragma unroll
              for (int e = 0; e < 4; ++e) { qv[2 * e] = bflo(qw[e]); qv[2 * e + 1] = bfhi(qw[e]); kv[h2][2 * e] = bflo(kw[e]); kv[h2][2 * e + 1] = bfhi(kw[e]); }
              if (latent) {
                  const int pos = (seg < 4) ? (2 * cidx + h2) : soff; const float* ct = ROPE + pos * 16 + (seg & 1) * 8; const float sgn = (seg & 2) ? 1.0f : -1.0f;
                  const f32x4 c0 = *(const f32x4*)(ct), c1 = *(const f32x4*)(ct + 4), s0 = *(const f32x4*)(ct + 2048), s1 = *(const f32x4*)(ct + 2052);
#pragma unroll
                  for (int e = 0; e < 8; ++e) { const float cs = e < 4 ? c0[e] : c1[e - 4], sn = (e < 4 ? s0[e] : s1[e - 4]) * sgn;
                      const float qp = dppf<DPP_XOR2>(qv[e]), kp = dppf<DPP_XOR2>(kv[h2][e]);
                      qv[e] = qv[e] * cs + qp * sn; kv[h2][e] = kv[h2][e] * cs + kp * sn; }
              }
              v4u qo, ko; qo.x = pk2(qv[0], qv[1]); qo.y = pk2(qv[2], qv[3]); qo.z = pk2(qv[4], qv[5]); qo.w = pk2(qv[6], qv[7]);
              ko.x = pk2(kv[h2][0], kv[h2][1]); ko.y = pk2(kv[h2][2], kv[h2][3]); ko.z = pk2(kv[h2][4], kv[h2][5]); ko.w = pk2(kv[h2][6], kv[h2][7]);
              *(LAS v4u*)(Qs + tau * LS + seg * 8) = qo; *(LAS v4u*)(Ks + tau * LS + seg * 8) = ko;
              kv[h2][0] = bflo(ko.x); kv[h2][1] = bfhi(ko.x); kv[h2][2] = bflo(ko.y); kv[h2][3] = bfhi(ko.y); kv[h2][4] = bflo(ko.z); kv[h2][5] = bfhi(ko.z); kv[h2][6] = bflo(ko.w); kv[h2][7] = bfhi(ko.w);
              const unsigned vw[4] = {rv_[h2].x, rv_[h2].y, rv_[h2].z, rv_[h2].w};
              const int tsw = (((tau >> 3) ^ seg) << 3) | (tau & 7);
#pragma unroll
              for (int e = 0; e < 4; ++e) { VTs[(seg * 8 + 2 * e) * LT + tsw] = (bf16)(vw[e] & 0xffffu); VTs[(seg * 8 + 2 * e + 1) * LT + tsw] = (bf16)(vw[e] >> 16); }
            }
            LDS_BARRIER();
#pragma unroll
            for (int h2 = 0; h2 < 2; ++h2) { const int off = soff + 64 * h2, tau = dir ? 127 - off : off; const float w = g_w[tau];
#pragma unroll
              for (int e = 0; e < 8; ++e) KwT[(seg * 8 + e) * LT + ((((tau >> 3) ^ seg) << 3) | (tau & 7))] = (bf16)f2bf(kv[h2][e] * w); }
            if (s + 1 < NSTEP) { const size_t tn = scan_tokbase2(s + 1, b, dir);
#pragma unroll
                for (int h2 = 0; h2 < 2; ++h2) { const bf16* pr = P + (tn + soff + 64 * h2) * 3072;
                    rq_[h2] = *(const v4u*)(pr + head * 64 + seg * 8); rk_[h2] = *(const v4u*)(pr + 512 + head * 64 + seg * 8); rv_[h2] = *(const v4u*)(pr + 1024 + head * 128 + vh * 64 + seg * 8);
 } }
            if (F.wave == 0 && s + 1 < NSTEP) { ML_GATE_SCAN(gbase + ((s + 1) & 1) * GSET); if (s + 2 < NSTEP) ML_GATE_LOAD(s + 2); }
            { int n = 0;
#pragma unroll
              for (int tt = 0; tt < 8; ++tt)
#pragma unroll
                  for (int sg = 0; sg <= tt; ++sg, ++n) if ((n % 7) + 1 == F.wave) {
                      const int tq = 16 * tt + fr, sg0 = 16 * sg + 4 * fq; f32x4 a = {0.f, 0.f, 0.f, 0.f};
#pragma unroll
                      for (int ks = 0; ks < 2; ++ks) { const bf16x8 kf = *(const LAS bf16x8*)(Ks + (16 * sg + fr) * LS + ks * 32 + fq * 8), qf = *(const LAS bf16x8*)(Qs + (16 * tt + fr) * LS + ks * 32 + fq * 8); a = MFMA16(kf, qf, a); }
                      const float Mt = g_M[tq]; float av[4];
#pragma unroll
                      for (int e = 0; e < 4; ++e) { const int sig = sg0 + e; av[e] = (sig <= tq) ? a[e] * fexp(g_u[sig] - Mt) : 0.f; }
                      v2u w; w.x = pk2(av[0], av[1]); w.y = pk2(av[2], av[3]);
                      *(LAS v2u*)(As + tq * LT + sg0) = w;
                      if (sg == tt && (tt & 1) == 0) *(LAS v2u*)(As + tq * LT + sg0 + 16) = (v2u){0u, 0u};
                  } }
            LDS_BARRIER();
            { const int tt = F.wave; const int tq = 16 * tt + fr;
              f32x4 acc[5];
#pragma unroll
              for (int x = 0; x < 5; ++x) acc[x] = (f32x4){0.f, 0.f, 0.f, 0.f};
#pragma unroll
              for (int ks = 0; ks < 2; ++ks) { const bf16x8 qf = *(const LAS bf16x8*)(Qs + tq * LS + ks * 32 + fq * 8);
#pragma unroll
                  for (int x = 0; x < 5; ++x) { const bf16x8 cf = *(const LAS bf16x8*)(CTc + (16 * x + fr) * LS + ks * 32 + fq * 8); acc[x] = MFMA16(cf, qf, acc[x]); } }
              const float it = g_in[tq];
#pragma unroll
              for (int x = 0; x < 5; ++x) acc[x] = acc[x] * it;
              for (int ks = 0; ks <= (tt >> 1); ++ks) { const bf16x8 af = *(const LAS bf16x8*)(As + tq * LT + ks * 32 + fq * 8);
#pragma unroll
                  for (int x = 0; x < 5; ++x) { const bf16x8 vf = *(const LAS bf16x8*)(VTs + (16 * x + fr) * LT + (((ks * 4 + fq) ^ ((2 * x + (fr >> 3)) & 7)) << 3)); acc[x] = MFMA16(vf, af, acc[x]); } }
              const float den = xrow_sum(fq == 0 ? acc[4][0] : 0.f);
              const float rden = 1.0f / fmaxf(fabsf(den), g_em[tq]);
              const int off = dir ? 127 - tq : tq;
              bf16* orow = HD + ((size_t)dir * TT + tb + off) * D + head * 128 + vh * 64 + 4 * fq;
#pragma unroll
              for (int x = 0; x < 4; ++x) { v2u w; w.x = pk2(acc[x][0] * rden, acc[x][1] * rden); w.y = pk2(acc[x][2] * rden, acc[x][3] * rden); *(v2u*)(orow + 16 * x) = w; }
            }
            { const int dt = F.wave & 3, eh = F.wave >> 2; const float dec = g_dec[0];
#pragma unroll
              for (int x = 0; x < 3; ++x) { if (x == 2 && eh != 0) continue; const int et = (x < 2) ? 2 * eh + x : 4;
                  st[x] = st[x] * dec;
#pragma unroll
                  for (int ks = 0; ks < 4; ++ks) { const bf16x8 vf = *(const LAS bf16x8*)(VTs + (16 * et + fr) * LT + (((ks * 4 + fq) ^ ((2 * et + (fr >> 3)) & 7)) << 3)), kf = *(const LAS bf16x8*)(KwT + (16 * dt + fr) * LT + (((ks * 4 + fq) ^ ((2 * dt + (fr >> 3)) & 7)) << 3)); st[x] = MFMA16(vf, kf, st[x]); }
#pragma unroll
                  for (int e = 0; e < 4; ++e) CTn[(16 * et + 4 * fq + e) * LS + 16 * dt + fr] = (bf16)f2bf(st[x][e]); } }
            LDS_BARRIER();
        }
    }
}
__device__ __forceinline__ void readout_phase(const Frame& F0, int M, const bf16* HD, const bf16* P, const float* ng, bf16* H) {
    Frame F = F0; asm volatile("" : "+v"(F.tid)); F.lane = F.tid & 63;
    for (int r = F.gw; r < M; r += F.NGW) {
        const int c = 16 * F.lane;
        const v4u f0 = *(const v4u*)(HD + (size_t)r * D + c), f1 = *(const v4u*)(HD + (size_t)r * D + c + 8);
        const v4u b0 = *(const v4u*)(HD + ((size_t)TT + r) * D + c), b1 = *(const v4u*)(HD + ((size_t)TT + r) * D + c + 8);
        const v4u o0 = *(const v4u*)(P + (size_t)r * 3072 + 2048 + c), o1 = *(const v4u*)(P + (size_t)r * 3072 + 2048 + c + 8);
        const unsigned fw[8] = {f0.x, f0.y, f0.z, f0.w, f1.x, f1.y, f1.z, f1.w}, bw[8] = {b0.x, b0.y, b0.z, b0.w, b1.x, b1.y, b1.z, b1.w}, ow[8] = {o0.x, o0.y, o0.z, o0.w, o1.x, o1.y, o1.z, o1.w};
        float h[16]; float ss = 0.f;
#pragma unroll
        for (int e = 0; e < 8; ++e) { h[2 * e] = bflo(fw[e]) + bflo(bw[e]); h[2 * e + 1] = bfhi(fw[e]) + bfhi(bw[e]); ss += h[2 * e] * h[2 * e] + h[2 * e + 1] * h[2 * e + 1]; }
        ss += dppf<DPP_XOR1>(ss); ss += dppf<DPP_XOR2>(ss); ss += dppf<DPP_HMIRROR>(ss);
        const float rs = 1.0f / sqrtf(ss * (1.0f / 128.0f) + NORM_EPS);
        unsigned ww[8];
#pragma unroll
        for (int e = 0; e < 8; ++e) { const float oa = bflo(ow[e]), ob = bfhi(ow[e]);
            const float va = h[2 * e] * rs * ng[c + 2 * e] / (1.0f + __expf(-oa)), vb = h[2 * e + 1] * rs * ng[c + 2 * e + 1] / (1.0f + __expf(-ob)); ww[e] = pk2(va, vb); }
        *(v4u*)(H + (size_t)r * D + c) = (v4u){ww[0], ww[1], ww[2], ww[3]}; *(v4u*)(H + (size_t)r * D + c + 8) = (v4u){ww[4], ww[5], ww[6], ww[7]};
    }
}

#ifndef DUPG
#define DUPG 1
#endif
#ifndef DUPNA
#define DUPNA 1
#endif
#ifndef DUPSCAN
#define DUPSCAN 1
#endif
#define REP_G for (int rep_ = 0; rep_ < DUPG; ++rep_)
#define REP_NA for (int rep_ = 0; rep_ < DUPNA; ++rep_)
#define REP_SCAN for (int rep_ = 0; rep_ < DUPSCAN; ++rep_)
#ifndef DUPMISC
#define DUPMISC 1
#endif
#ifndef DUPMIX
#define DUPMIX 1
#endif
#ifndef DUPBAR
#define DUPBAR 1
#endif
#ifndef STAG
#define STAG 0
#endif
#ifndef DUPF1
#define DUPF1 1
#endif
#ifndef DUPF2
#define DUPF2 1
#endif
#define REP_F1 for (int rep_ = 0; rep_ < DUPF1; ++rep_)
#define REP_F2 for (int rep_ = 0; rep_ < DUPF2; ++rep_)
#ifndef DUPG1U
#define DUPG1U 1
#endif
#ifndef DUPG1V
#define DUPG1V 1
#endif
#define REP_G1U for (int rep_ = 0; rep_ < DUPG1U; ++rep_)
#define REP_G1V for (int rep_ = 0; rep_ < DUPG1V; ++rep_)
#define REP_MISC for (int rep_ = 0; rep_ < DUPMISC; ++rep_)

struct Args { const float* in[25]; float* out; unsigned char* ws; };
__global__ void __launch_bounds__(NTHREADS, 2) fwd_kernel(Args args) {
    extern __shared__ __attribute__((aligned(16))) unsigned char lds_raw[];
    Frame F;
    F.lds = (LAS unsigned char*)lds_raw;
    F.tid = threadIdx.x; F.lane = F.tid & 63; F.wave = __builtin_amdgcn_readfirstlane(F.tid >> 6);
    F.G = gridDim.x; F.gw = blockIdx.x * NWAVES + F.wave; F.NGW = F.G * NWAVES;
#pragma unroll
    for (int i = 0; i < 25; ++i) F.in[i] = args.in[i];
    F.out = args.out; F.ws = args.ws;
    unsigned char* ws = args.ws;
    for (int u = F.tid; u < (LDS_BYTES - LDSCTL_OFF) / 4; u += NTHREADS) ((LAS unsigned*)(F.lds + LDSCTL_OFF))[u] = 0u;
    __syncthreads();
    XcdBarrier bar = xcd_barrier_post((unsigned*)(ws + WS_CTL) + CW_BAR, (volatile LAS unsigned*)(F.lds + MISC_OFF) + 8);
#define GRID_BAR() do { for (int rb_ = 0; rb_ < DUPBAR; ++rb_) xcd_barrier(bar); } while (0)
    float* MODS = (float*)(ws + WS_MODS);
    bf16* WA = (bf16*)(ws + WS_WA); bf16* WB = (bf16*)(ws + WS_WB);
    bf16* HBUF = (bf16*)F.out;
    bf16* X16 = (bf16*)(ws + WS_HBUF);
    bf16* Y = (bf16*)(ws + WS_Y); float* PART = (float*)(ws + WS_Y + 132 * MiB);
    float* ST = (float*)(ws + WS_STATS);
    const float* norm_g = F.in[6];
    LAS unsigned char* ring = F.lds + RING_OFF;

    REP_MISC { mods_phase(F);
    convert_layer(F, 0, WA);
    convert_layer(F, 1, WB); }
    GRID_BAR();
    REP_MISC row_phase<false, true, false, false>(F, TT, F.in[0], F.in[2], nullptr, nullptr, nullptr, nullptr, nullptr, nullptr, norm_g, MODS + 1024, MODS, HBUF);
    GRID_BAR();

    for (int layer = 0; layer < DEPTH; ++layer) {
        const int kind = layer % 3, j = layer / 3, M = (layer == DEPTH - 1) ? TLAT : TT;
        const int M2 = (layer >= DEPTH - 2) ? TLAT : TT;
        bf16* WR = (layer & 1) ? WB : WA;
        const float* mods_l = MODS + (size_t)layer * 9 * 6144;
        if (kind == 0) {
            bf16* U = (bf16*)(ws + WS_GM_U); bf16* VT = (bf16*)(ws + WS_GM_VT);
            const float* b_in = F.in[10] + (size_t)j * 6144;
            REP_G1U { pg8::Gemm g{HBUF, WR + WO_GM_IN, M, GH, D, D, 0}; pg8::StaticOrder S; S.init(M, GH, F.G, (int)blockIdx.x);
              pg8::EpiBf16<1> E{U, GH, b_in, 0, 0, 1.f};
              pg8::gemm_phase<pg8::EpiBf16<1>, pg8::StaticOrder, true, true>(ring, g, S, E, STAG); }
            REP_G1V { pg8::Gemm g{WR + WO_GM_IN + (size_t)GH * D, HBUF, GH, M, D, D, 0}; pg8::StaticOrder S; S.init(GH, M, F.G, (int)blockIdx.x);
              pg8::EpiSwap<1, 0, true> E{VT, b_in + GH, ST};
              pg8::gemm_phase<pg8::EpiSwap<1, 0, true>, pg8::StaticOrder, true, true>(ring, g, S, E, STAG); }
            GRID_BAR();
            for (int rep_ = DUPMIX - 1; rep_ >= 0; --rep_) mix_phase(F, rep_ != 0 && ((const unsigned*)(ws + WS_CTL))[8] == 0u, M / 128, VT, U, ST, F.in[12] + (size_t)j * 8 * 128 * 128, F.in[13] + (size_t)j * 8 * 128, F.in[11] + (size_t)j * GH);
            GRID_BAR();
            REP_G { pg8::Gemm g{U, WR + WO_GM_OUT, TLAT, D, GH, GH, 0}; pg8::StaticOrder S; S.init(TLAT, D, F.G, (int)blockIdx.x);
              pg8::EpiBf16<0, false> E{Y, D, nullptr, 0, 0, 1.f};
              pg8::gemm_phase<pg8::EpiBf16<0, false>, pg8::StaticOrder, true, true>(ring, g, S, E); }
            if (M == TT) { pg8::Gemm g{U + (size_t)TLAT * GH, WR + WO_GM_OUT, TCTX, D, GH, GH / 8, (size_t)(GH / 8) * 2}; pg8::SplitOrder S; S.init(8, F.G, (int)blockIdx.x);
              pg8::EpiF32P E{PART};
              pg8::gemm_phase<pg8::EpiF32P, pg8::SplitOrder, true, true>(ring, g, S, E); }
            GRID_BAR();
        } else if (kind == 1) {
            bf16* Q = (bf16*)(ws + WS_NA_Q); bf16* Kb = (bf16*)(ws + WS_NA_K); bf16* VT = (bf16*)(ws + WS_NA_VT); bf16* O = (bf16*)(ws + WS_NA_O);
            const float* b_qkv = F.in[16];
            REP_G { pg8::Gemm g{HBUF, WR + WO_NA_QKV, M, 2048, D, D, 0}; pg8::StaticOrder S; S.init(M, 2048, F.G, (int)blockIdx.x);
              pg8::EpiBf16<0> E{Q, D, b_qkv, 1024, (size_t)(WS_NA_K - WS_NA_Q) / 2, 0.125f * 1.4426950408889634f};
              pg8::gemm_phase<pg8::EpiBf16<0>, pg8::StaticOrder, true, true>(ring, g, S, E, STAG); }
            REP_G { pg8::Gemm g{WR + WO_NA_QKV + (size_t)2048 * D, HBUF, D, M, D, D, 0}; pg8::StaticOrder S; S.init(D, M, F.G, (int)blockIdx.x);
              pg8::EpiSwap<0, 1, false> E{VT, b_qkv + 2048, nullptr};
              pg8::gemm_phase<pg8::EpiSwap<0, 1, false>, pg8::StaticOrder, true, true>(ring, g, S, E); }
            GRID_BAR();
            REP_NA na_phase(F, Q, Kb, VT, O, F.in[17]);
            GRID_BAR();
            REP_G { pg8::Gemm g{O, WR + WO_NA_O, TLAT, D, D, D, 0}; pg8::StaticOrder S; S.init(TLAT, D, F.G, (int)blockIdx.x);
              pg8::EpiBf16<0> E{Y, D, F.in[19], 0, 0, 1.f};
              pg8::gemm_phase<pg8::EpiBf16<0>, pg8::StaticOrder, true, true>(ring, g, S, E); }
            { pg8::Gemm g{O + (size_t)TLAT * D, WR + WO_NA_O, TCTX, D, D, D / 4, (size_t)(D / 4) * 2}; pg8::SplitOrder S; S.init(4, F.G, (int)blockIdx.x);
              pg8::EpiF32P E{PART};
              pg8::gemm_phase<pg8::EpiF32P, pg8::SplitOrder, true, true>(ring, g, S, E); }
            GRID_BAR();
        } else {
            bf16* P = (bf16*)(ws + WS_ML_P); float* Gt = (float*)(ws + WS_ML_G); bf16* HD = (bf16*)(ws + WS_ML_HD);
            REP_G { pg8::Gemm g{HBUF, WR + WO_ML_IN, M, 3328, D, D, 0}; pg8::StaticOrder S; S.init(M, 3328, F.G, (int)blockIdx.x);
              pg8::EpiMl E{P, Gt, F.in[22]};
              pg8::gemm_phase<pg8::EpiMl, pg8::StaticOrder, true, true>(ring, g, S, E, STAG); }
            GRID_BAR();
            REP_SCAN scan_phase(F, P, Gt, HD, (const float*)(ws + WS_ROPE));
            GRID_BAR();
            REP_MISC readout_phase(F, M2, HD, P, F.in[23], HBUF);
            GRID_BAR();
            REP_G { pg8::Gemm g{HBUF, WR + WO_ML_OUT, M2, D, D, D, 0}; pg8::StaticOrder S; S.init(M2, D, F.G, (int)blockIdx.x);
              pg8::EpiBf16<0, false> E{Y, D, nullptr, 0, 0, 1.f};
              pg8::gemm_phase<pg8::EpiBf16<0, false>, pg8::StaticOrder, true, true>(ring, g, S, E); }
            GRID_BAR();
        }
        if (layer == 0) row_phase<true, true, false, true>(F, M2, F.in[0], F.in[2], nullptr, nullptr, X16, Y, norm_g + ((size_t)layer * 4 + 1) * D, mods_l + 2 * 1024,
                              norm_g + ((size_t)layer * 4 + 2) * D, mods_l + 4 * 1024, mods_l + 3 * 1024, HBUF, PART, 8, nullptr);
        else row_phase<true, true, true, true>(F, M2, nullptr, nullptr, X16, nullptr, X16, Y, norm_g + ((size_t)layer * 4 + 1) * D, mods_l + 2 * 1024,
                              norm_g + ((size_t)layer * 4 + 2) * D, mods_l + 4 * 1024, mods_l + 3 * 1024, HBUF, PART, 4, kind == 1 ? F.in[19] : nullptr);
        GRID_BAR();
        const size_t o_w1 = kind == 0 ? WO_GM_W1 : kind == 1 ? WO_NA_W1 : WO_ML_W1, o_w2 = kind == 0 ? WO_GM_W2 : kind == 1 ? WO_NA_W2 : WO_ML_W2;
        { bf16* HID = (bf16*)(ws + WS_HID);
#if defined(PROBE_EPI)
          { pg8::Gemm g{HBUF, WR + o_w1, M2, FF, D, D, 0}; pg8::StaticOrder S; S.init(M2, FF, F.G, (int)blockIdx.x);
            pg8::EpiProbe<PROBE_EPI> E{HID, FF};
            pg8::gemm_phase<pg8::EpiProbe<PROBE_EPI>, pg8::StaticOrder, true, true>(ring, g, S, E, STAG); }
#endif
          REP_F1 { pg8::Gemm g{HBUF, WR + o_w1, M2, FF, D, D, 0}; pg8::StaticOrder S; S.init(M2, FF, F.G, (int)blockIdx.x);
            pg8::EpiBf16<2, false> E{HID, FF, nullptr, 0, 0, 1.f};
            pg8::gemm_phase<pg8::EpiBf16<2, false>, pg8::StaticOrder, true, true>(ring, g, S, E, STAG); }
          GRID_BAR();
          REP_F2 { pg8::Gemm g{HID, WR + o_w2, TLAT, D, FF, FF, 0}; pg8::StaticOrder S; S.init(TLAT, D, F.G, (int)blockIdx.x);
            pg8::EpiBf16<0, false> E{Y, D, nullptr, 0, 0, 1.f};
            pg8::gemm_phase<pg8::EpiBf16<0, false>, pg8::StaticOrder, true, true>(ring, g, S, E); }
          if (M2 == TT) { pg8::Gemm g{HID + (size_t)TLAT * FF, WR + o_w2, TCTX, D, FF, FF / 8, (size_t)(FF / 8) * 2}; pg8::SplitOrder S; S.init(8, F.G, (int)blockIdx.x);
            pg8::EpiF32P E{PART};
            pg8::gemm_phase<pg8::EpiF32P, pg8::SplitOrder, true, true>(ring, g, S, E); }
          GRID_BAR(); }
        if (layer < DEPTH - 1) {
            const float* mods_n = MODS + (size_t)(layer + 1) * 9 * 6144;
            const int Mn = (layer + 1 == DEPTH - 1) ? TLAT : TT;
            row_phase<true, true, true, true>(F, Mn, nullptr, nullptr, X16, nullptr, X16, Y, norm_g + ((size_t)layer * 4 + 3) * D, mods_l + 5 * 1024,
                                  norm_g + ((size_t)(layer + 1) * 4 + 0) * D, mods_n + 1 * 1024, mods_n + 0 * 1024, HBUF, PART, 8, nullptr);
            if (layer + 2 < DEPTH) convert_layer(F, layer + 2, WR);
            GRID_BAR();
        } else {
            row_phase<true, false, true, false>(F, TLAT, nullptr, nullptr, X16, F.out, nullptr, Y, norm_g + ((size_t)layer * 4 + 3) * D, mods_l + 5 * 1024, nullptr, nullptr, nullptr, nullptr);
        }
    }
}

extern "C" void kernel_launch(void* const* d_in, const int* in_sizes, int n_in, void* d_out, int out_size, void* d_ws, size_t ws_size, hipStream_t stream) {
    static int grid = 0;
    if (grid == 0) {
        if (n_in != 25 || out_size != TLAT * D || ws_size < WS_NEED) { fprintf(stderr, "kernel_launch: unexpected shapes: n_in %d out %d ws %zu (need %zu)\n", n_in, out_size, ws_size, (size_t)WS_NEED); grid = -1; return; }
        int dev = 0, cus = 0, per_cu = 0;
        if (hipGetDevice(&dev) != hipSuccess || hipDeviceGetAttribute(&cus, hipDeviceAttributeMultiprocessorCount, dev) != hipSuccess) { grid = -1; return; }
        if (hipFuncSetAttribute((const void*)fwd_kernel, hipFuncAttributeMaxDynamicSharedMemorySize, LDS_BYTES) != hipSuccess) { fprintf(stderr, "kernel_launch: hipFuncSetAttribute failed\n"); grid = -1; return; }
        if (hipOccupancyMaxActiveBlocksPerMultiprocessor(&per_cu, (const void*)fwd_kernel, NTHREADS, LDS_BYTES) != hipSuccess || per_cu < 1)
            fprintf(stderr, "kernel_launch: occupancy query reports %d workgroups per CU\n", per_cu);
        (void)hipGetLastError();
        grid = cus;
    }
    if (grid < 0) return;
    if (hipMemsetAsync((char*)d_ws + WS_CTL, 0, CTL_ZERO_BYTES, stream) != hipSuccess) return;
    Args a{};
    for (int i = 0; i < 25; ++i) a.in[i] = (const float*)d_in[i];
    a.out = (float*)d_out; a.ws = (unsigned char*)d_ws;
    hipLaunchKernelGGL(fwd_kernel, dim3(grid), dim3(NTHREADS), LDS_BYTES, stream, a);
}
```
